# Optimizing an MI355X kernel written in HIP

```python
import math
import jax, jax.numpy as jnp
from jax import lax
import numpy as np

D_MODEL = 1024
BATCH = 8
SEQ = 4096
DEPTH = 2

PLE_DIM = 256
HEAD_DIM = 128
MIX_WIDTH = D_MODEL
N_HEADS_A = MIX_WIDTH // (2 * HEAD_DIM)
A_QK_DIM = HEAD_DIM // 2
A_V_DIM = HEAD_DIM
N_HEADS_B = MIX_WIDTH // (2 * HEAD_DIM)
N_HEADS_C = MIX_WIDTH // HEAD_DIM
ROPE_THETA = 500000.0
ROPE_FRACTION = 4
QBLK = 128
DILATED_PATTERNS = ((128, 1), (512, 4), (2048, 16))
FORGET_BIAS_INIT = 2.0
RMS_EPS = 1e-6
N_EVEN = (DEPTH + 1) // 2
N_ODD = DEPTH // 2
A_QK_WIDTH = N_HEADS_A * 2 * A_QK_DIM
A_V_WIDTH = N_HEADS_A * A_V_DIM
B_WIDTH = N_HEADS_B * HEAD_DIM
EVEN_IN = 2 * A_QK_WIDTH + A_V_WIDTH + 3 * B_WIDTH + N_HEADS_B + MIX_WIDTH
ODD_IN = 4 * MIX_WIDTH

kernel_name = 'hybrid_diff_fox_dilated_block'


def rms_norm(x, g):
    x32 = x.astype(jnp.float32)
    y = x32 * lax.rsqrt(jnp.mean(x32 * x32, axis=-1, keepdims=True) + RMS_EPS)
    return (y * g.astype(jnp.float32)).astype(x.dtype)


def partial_rope(x, positions):
    rot = x.shape[-1] // ROPE_FRACTION
    half = rot // 2
    inv_freq = jnp.exp(-math.log(ROPE_THETA) * jnp.arange(half, dtype=jnp.float32) / half)
    ang = positions.astype(jnp.float32)[..., None] * inv_freq
    ang = ang.reshape(ang.shape[:2] + (1,) * (x.ndim - 3) + (half,))
    cos, sin = jnp.cos(ang), jnp.sin(ang)
    x1 = x[..., :half].astype(jnp.float32)
    x2 = x[..., half:rot].astype(jnp.float32)
    out = jnp.concatenate([x1 * cos - x2 * sin, x2 * cos + x1 * sin,
                           x[..., rot:].astype(jnp.float32)], axis=-1)
    return out.astype(x.dtype)


def to_qblocks(t):
    b, s = t.shape[:2]
    return jnp.moveaxis(t.reshape((b, s // QBLK, QBLK) + t.shape[2:]), 1, 0)


def from_qblocks(t):
    nb, b = t.shape[:2]
    return jnp.moveaxis(t, 0, 1).reshape((b, nb * QBLK) + t.shape[3:])


def diff_attention(q1, q2, k1, k2, v, lam):
    s_len = k1.shape[1]
    kpos = jnp.arange(s_len)

    def one_block(args):
        q1b, q2b, t0 = args
        causal = (t0 + jnp.arange(QBLK))[:, None] >= kpos[None, :]

        def probs(qb, k):
            s = jnp.einsum('bqhd,bkhd->bhqk', qb, k).astype(jnp.float32)
            return jax.nn.softmax(jnp.where(causal, s, -jnp.inf), axis=-1)

        w = probs(q1b, k1) - lam * probs(q2b, k2)
        return jnp.einsum('bhqk,bkhd->bqhd', w.astype(v.dtype), v)

    t0s = jnp.arange(s_len // QBLK, dtype=jnp.int32) * QBLK
    return from_qblocks(lax.map(one_block, (to_qblocks(q1), to_qblocks(q2), t0s)))


def fox_attention(q, k, v, cum_logf):
    s_len = k.shape[1]
    kpos = jnp.arange(s_len)
    c_k = jnp.swapaxes(cum_logf, 1, 2)

    def one_block(args):
        qb, cqb, t0 = args
        causal = (t0 + jnp.arange(QBLK))[:, None] >= kpos[None, :]
        s = jnp.einsum('bqhd,bkhd->bhqk', qb, k).astype(jnp.float32)
        s = s + jnp.swapaxes(cqb, 1, 2)[..., None] - c_k[:, :, None, :]
        pr = jax.nn.softmax(jnp.where(causal, s, -jnp.inf), axis=-1)
        return jnp.einsum('bhqk,bkhd->bqhd', pr.astype(v.dtype), v)

    t0s = jnp.arange(s_len // QBLK, dtype=jnp.int32) * QBLK
    return from_qblocks(lax.map(one_block, (to_qblocks(q), to_qblocks(cum_logf), t0s)))


def dilated_window_attention(q, k, v, window, dil):
    b, s_len, h, d = q.shape
    steps = window // dil
    blk = steps
    span = blk * dil
    s_pad = -(-s_len // span) * span
    pad = ((0, 0), (0, s_pad - s_len), (0, 0), (0, 0))
    q, k, v = jnp.pad(q, pad), jnp.pad(k, pad), jnp.pad(v, pad)
    nb = s_pad // span

    def split(t):
        return t.reshape(b, nb, blk, dil, h, d)

    def with_prev(t):
        prev = jnp.pad(t[:, :-1], ((0, 0), (1, 0), (0, 0), (0, 0), (0, 0), (0, 0)))
        return jnp.concatenate([prev, t], axis=2)

    qb = split(q)
    kk, vv = with_prev(split(k)), with_prev(split(v))
    s = jnp.einsum('bnqrhd,bnkrhd->bnrhqk', qb, kk).astype(jnp.float32)
    dist = jnp.arange(blk)[:, None] + blk - jnp.arange(2 * blk)[None, :]
    band = (dist >= 0) & (dist <= steps)
    exists = (jnp.arange(nb)[:, None, None] > 0) | (jnp.arange(2 * blk)[None, None, :] >= blk)
    valid = band[None] & exists
    s = jnp.where(valid[None, :, None, None], s, -jnp.inf)
    lse = jax.nn.logsumexp(s, axis=-1)
    pr = jnp.exp(s - lse[..., None])
    o = jnp.einsum('bnrhqk,bnkrhd->bnqrhd', pr.astype(v.dtype), vv)
    o = o.reshape(b, s_pad, h, d)[:, :s_len]
    lse = jnp.transpose(lse, (0, 1, 4, 2, 3)).reshape(b, s_pad, h)[:, :s_len]
    return o, lse


def even_layer(h, positions, norm_g, w_in, b_forget, qn_a, kn_a, qn_b, kn_b,
               lam_q1, lam_k1, lam_q2, lam_k2, subln_g, w_out, lam_init):
    b, s_len, _ = h.shape
    hn = rms_norm(h, norm_g)
    proj = hn @ w_in
    sizes = (A_QK_WIDTH, A_QK_WIDTH, A_V_WIDTH, B_WIDTH, B_WIDTH, B_WIDTH, N_HEADS_B)
    cuts, acc = [], 0
    for sz in sizes:
        acc += sz
        cuts.append(acc)
    qa, ka, va, qb, kb, vb, f_logit, z = jnp.split(proj, cuts, axis=-1)

    qa = partial_rope(rms_norm(qa.reshape(b, s_len, N_HEADS_A, 2, A_QK_DIM), qn_a), positions)
    qa = qa * (A_QK_DIM ** -0.5)
    ka = partial_rope(rms_norm(ka.reshape(b, s_len, N_HEADS_A, 2, A_QK_DIM), kn_a), positions)
    lam = (jnp.exp(jnp.sum(lam_q1.astype(jnp.float32) * lam_k1.astype(jnp.float32)))
           - jnp.exp(jnp.sum(lam_q2.astype(jnp.float32) * lam_k2.astype(jnp.float32)))
           + lam_init)
    oa = diff_attention(qa[..., 0, :], qa[..., 1, :], ka[..., 0, :], ka[..., 1, :],
                        va.reshape(b, s_len, N_HEADS_A, A_V_DIM), lam)
    oa = rms_norm(oa, subln_g) * (1.0 - lam_init)

    qb = rms_norm(qb.reshape(b, s_len, N_HEADS_B, HEAD_DIM), qn_b) * (HEAD_DIM ** -0.5)
    kb = rms_norm(kb.reshape(b, s_len, N_HEADS_B, HEAD_DIM), kn_b)
    cum_logf = jnp.cumsum(jax.nn.log_sigmoid((f_logit + b_forget).astype(jnp.float32)), axis=1)
    ob = fox_attention(qb, kb, vb.reshape(b, s_len, N_HEADS_B, HEAD_DIM), cum_logf)

    mixed = jnp.concatenate([oa.reshape(b, s_len, A_V_WIDTH), ob.reshape(b, s_len, B_WIDTH)],
                            axis=-1) * jax.nn.silu(z)
    return h + mixed @ w_out


def odd_layer(h, positions, norm_g, w_in, qn_c, kn_c, w_out):
    b, s_len, _ = h.shape
    hn = rms_norm(h, norm_g)
    proj = hn @ w_in
    q, k, v, z = jnp.split(proj, [MIX_WIDTH, 2 * MIX_WIDTH, 3 * MIX_WIDTH], axis=-1)
    q = partial_rope(rms_norm(q.reshape(b, s_len, N_HEADS_C, HEAD_DIM), qn_c), positions)
    q = q * (HEAD_DIM ** -0.5)
    k = partial_rope(rms_norm(k.reshape(b, s_len, N_HEADS_C, HEAD_DIM), kn_c), positions)
    v = v.reshape(b, s_len, N_HEADS_C, HEAD_DIM)
    outs, lses = [], []
    for window, dil in DILATED_PATTERNS:
        o_i, lse_i = dilated_window_attention(q, k, v, window, dil)
        outs.append(o_i)
        lses.append(lse_i)
    wts = jax.nn.softmax(jnp.stack(lses), axis=0)
    o = jnp.sum(wts[..., None] * jnp.stack(outs).astype(jnp.float32), axis=0).astype(h.dtype)
    mixed = o.reshape(b, s_len, MIX_WIDTH) * jax.nn.silu(z)
    return h + mixed @ w_out


def per_layer_embedding(h, p_i, w_ple, w_gate):
    return h + (p_i @ w_ple) * jax.nn.sigmoid(h @ w_gate)


def setup_inputs(seed: int = 0) -> dict:
    key = jax.random.key(seed)
    ks = jax.random.split(key, 24)

    def nrm(k, shape, scale):
        return scale * jax.random.normal(k, shape, jnp.float32)

    def gain(k, shape):
        return 1.0 + 0.02 * jax.random.normal(k, shape, jnp.float32)

    positions = (jnp.arange(SEQ, dtype=jnp.int32)[None, :]
                 + jax.random.randint(ks[2], (BATCH, 1), 0, 1024, dtype=jnp.int32))
    return {
        'x': nrm(ks[0], (BATCH, SEQ, D_MODEL), 1.0),
        'p': nrm(ks[1], (DEPTH, BATCH, SEQ, PLE_DIM), 1.0),
        'positions': positions,
        'norm_g': gain(ks[3], (DEPTH, D_MODEL)),
        'w_in_even': nrm(ks[4], (N_EVEN, D_MODEL, EVEN_IN), D_MODEL ** -0.5),
        'b_forget': FORGET_BIAS_INIT + 0.1 * jax.random.normal(ks[5], (N_EVEN, N_HEADS_B), jnp.float32),
        'qn_a': gain(ks[6], (N_EVEN, A_QK_DIM)),
        'kn_a': gain(ks[7], (N_EVEN, A_QK_DIM)),
        'qn_b': gain(ks[8], (N_EVEN, HEAD_DIM)),
        'kn_b': gain(ks[9], (N_EVEN, HEAD_DIM)),
        'lam_q1': nrm(ks[10], (N_EVEN, A_QK_DIM), 0.1),
        'lam_k1': nrm(ks[11], (N_EVEN, A_QK_DIM), 0.1),
        'lam_q2': nrm(ks[12], (N_EVEN, A_QK_DIM), 0.1),
        'lam_k2': nrm(ks[13], (N_EVEN, A_QK_DIM), 0.1),
        'subln_g': gain(ks[14], (N_EVEN, A_V_DIM)),
        'w_out_even': nrm(ks[15], (N_EVEN, MIX_WIDTH, D_MODEL), MIX_WIDTH ** -0.5),
        'w_in_odd': nrm(ks[16], (N_ODD, D_MODEL, ODD_IN), D_MODEL ** -0.5),
        'qn_c': gain(ks[17], (N_ODD, HEAD_DIM)),
        'kn_c': gain(ks[18], (N_ODD, HEAD_DIM)),
        'w_out_odd': nrm(ks[19], (N_ODD, MIX_WIDTH, D_MODEL), MIX_WIDTH ** -0.5),
        'w_ple': nrm(ks[20], (DEPTH, PLE_DIM, D_MODEL), PLE_DIM ** -0.5),
        'w_ple_gate': nrm(ks[21], (DEPTH, D_MODEL, D_MODEL), D_MODEL ** -0.5),
    }


def reference(x, p, positions, norm_g, w_in_even, b_forget, qn_a, kn_a, qn_b, kn_b,
              lam_q1, lam_k1, lam_q2, lam_k2, subln_g, w_out_even,
              w_in_odd, qn_c, kn_c, w_out_odd, w_ple, w_ple_gate):
    h = x
    for i in range(DEPTH):
        if i % 2 == 0:
            e = i // 2
            lam_init = 0.8 - 0.6 * math.exp(-0.3 * i)
            h = even_layer(h, positions, norm_g[i], w_in_even[e], b_forget[e], qn_a[e], kn_a[e],
                           qn_b[e], kn_b[e], lam_q1[e], lam_k1[e], lam_q2[e], lam_k2[e],
                           subln_g[e], w_out_even[e], lam_init)
        else:
            o = i // 2
            h = odd_layer(h, positions, norm_g[i], w_in_odd[o], qn_c[o], kn_c[o], w_out_odd[o])
        h = per_layer_embedding(h, p[i], w_ple[i], w_ple_gate[i])
    return h
```

```cpp
#include <hip/hip_runtime.h>
#include <hip/hip_bf16.h>
#include <hip/hip_cooperative_groups.h>
#include <cstdio>
#include <cstdint>
#include <cmath>
namespace cg = cooperative_groups;
namespace pg8 {
#define PG8_LAS __attribute__((address_space(3)))
typedef unsigned short bf16_t;
typedef short bf16x8 __attribute__((ext_vector_type(8)));
typedef float f32x4 __attribute__((ext_vector_type(4)));
typedef unsigned u32x4 __attribute__((ext_vector_type(4)));
constexpr int BM = 256, BK = 64, HALF = 128, HTB = HALF * BK * 2  , STAGE_BYTES = 8 * HTB, NXCD = 8, WGM = 8;

__host__ __device__ __forceinline__ int lds_byte(int r, int c) { const int st = (r >> 4) * 2 + (c >> 5), rr = r & 15, cc = c & 31, ob = rr * 64 + cc * 2; return st * 1024 + (ob ^ (((ob >> 9) & 1) << 5)); }
__host__ __device__ __forceinline__ void stage_rc(int b, int& R, int& C) { const int st = b / 1024, sb = b % 1024, swz = sb ^ (((sb >> 9) & 1) << 5); R = (st >> 1) * 16 + swz / 64; C = (st & 1) * 32 + (swz % 64) / 2; }
__host__ __device__ __forceinline__ int perm32(int rho) { const int n = rho >> 4, i = rho & 15; return 8 * (i >> 2) + 4 * n + (i & 3); }

struct Unit { int pm, pn; };
struct Gemm { const bf16_t* A; const bf16_t* Bt; int M, N, K; };

struct StaticOrder {
    int nM, nN, nwg, G, c;
    __host__ __device__ void init(int M, int N, int G_, int c_) { nM = M / BM; nN = N / BM; nwg = nM * nN; G = G_; c = c_; }
    __host__ __device__ bool next(int i, Unit& u) const {
        const long L = (long)i * G + c; if (L >= nwg) return false;
        int wgid = (int)L; { const int q = nwg / NXCD, r = nwg % NXCD, xcd = wgid % NXCD, off = wgid / NXCD; wgid = (xcd < r ? xcd * (q + 1) : r * (q + 1) + (xcd - r) * q) + off; }
        const int nig = WGM * nN, gid = wgid / nig, fm = gid * WGM, gsz = (nM - fm) < WGM ? (nM - fm) : WGM;
        u.pm = fm + ((wgid % nig) % gsz); u.pn = (wgid % nig) / gsz; return true;
    }
    __device__ __forceinline__ void a_ready(const Unit&) const {}
    __device__ __forceinline__ void done(const Unit&) const {}
};

__device__ __forceinline__ unsigned cvt_pk_bf16(float lo, float hi) { unsigned r; asm volatile("v_cvt_pk_bf16_f32 %0, %1, %2" : "=v"(r) : "v"(lo), "v"(hi)); return r; }
typedef float f32x2 __attribute__((ext_vector_type(2)));
__device__ __forceinline__ f32x2 gelu_pk(f32x2 v) {
    const f32x2 av = __builtin_elementwise_abs(v), d = av * 0.2316418882f + 1.0f;
    f32x2 t; t.x = __builtin_amdgcn_rcpf(d.x); t.y = __builtin_amdgcn_rcpf(d.y);
    f32x2 q = t * 0.5307027145f + (-0.7265760135f); q = q * t + 0.7107068705f; q = q * t + (-0.142248368f); q = q * t + 0.127414796f; q = q * t;
    const f32x2 s = (v * v) * (-0.72134752044f);
    f32x2 e; e.x = __builtin_amdgcn_exp2f(s.x); e.y = __builtin_amdgcn_exp2f(s.y);
    const f32x2 m = v * (q * e), r = v - m;
    f32x2 o; o.x = v.x < 0.f ? m.x : r.x; o.y = v.y < 0.f ? m.y : r.y; return o;
}

template <int ACT  > struct EpiBf16 {
    static constexpr bool PERM = true, AFTER_DRAIN = false; static_assert(ACT == 0 || ACT == 1, "EpiBf16: ACT is 0 (none) or 1 (gelu_pk)");
    bf16_t* O; int ldc; const float* bias; int split_cols; size_t split_stride; float scale0;
    __device__ __forceinline__ void operator()(const f32x4 (&acc)[2][2][4][2], const Unit& u, int wr, int wc, int fr, int fq) const {
        const int row0 = u.pm * BM + wr * 64 + fr; int colt = u.pn * BM; bf16_t* base = O;
        float sc = 1.f; if (split_cols) { const int t = colt / split_cols; base += (size_t)t * split_stride; colt -= t * split_cols; if (t == 0) sc = scale0; }
        const int col0 = colt + wc * 32 + 8 * fq, bcol0 = u.pn * BM + wc * 32 + 8 * fq;
        f32x4 bv[2][2];
#pragma unroll
        for (int bj = 0; bj < 2; ++bj)
#pragma unroll
            for (int n = 0; n < 2; ++n) bv[bj][n] = bias ? *(const f32x4*)(bias + bcol0 + bj * HALF + 4 * n) : (f32x4){0.f, 0.f, 0.f, 0.f};
#pragma unroll
        for (int ai = 0; ai < 2; ++ai)
#pragma unroll
            for (int m = 0; m < 4; ++m) { bf16_t* rowp = base + (size_t)(row0 + ai * HALF + m * 16) * ldc + col0;
#pragma unroll
                for (int bj = 0; bj < 2; ++bj) { f32x4 v0 = acc[ai][bj][m][0] + bv[bj][0], v1 = acc[ai][bj][m][1] + bv[bj][1];
                    if (ACT == 1) { f32x2 a = gelu_pk((f32x2){v0[0], v0[1]}), b = gelu_pk((f32x2){v0[2], v0[3]}), c = gelu_pk((f32x2){v1[0], v1[1]}), d = gelu_pk((f32x2){v1[2], v1[3]});
                        v0 = (f32x4){a.x, a.y, b.x, b.y}; v1 = (f32x4){c.x, c.y, d.x, d.y}; }
                    v0 = v0 * sc; v1 = v1 * sc; u32x4 w; w.x = cvt_pk_bf16(v0[0], v0[1]); w.y = cvt_pk_bf16(v0[2], v0[3]); w.z = cvt_pk_bf16(v1[0], v1[1]); w.w = cvt_pk_bf16(v1[2], v1[3]);
                    *(u32x4*)(rowp + bj * HALF) = w; } }
    }
};
template <class Epi, class Sched, bool ALIGN_EPI = false, bool SP2 = false>
__device__ __forceinline__ void gemm_phase(PG8_LAS unsigned char* lds, const Gemm g, const Sched& S, const Epi& E) {
    int tid_l = threadIdx.x; asm volatile("" : "+v"(tid_l));
    const int tid = tid_l, wid = __builtin_amdgcn_readfirstlane(tid >> 6), lane = tid & 63, wr = wid >> 2, wc = wid & 3, fr = lane & 15, fq = lane >> 4;
    int K_l = g.K; asm volatile("" : "+s"(K_l));
    const int K = K_l, nt = K / BK;
    unsigned voffA[2], voffB[2];
#pragma unroll
    for (int i = 0; i < 2; ++i) { int R, C; stage_rc(tid * 16 + i * 8192, R, C); const int Rb = Epi::PERM ? ((R & ~31) + perm32(R & 31)) : R;
        voffA[i] = (unsigned)(R * K + C) * 2u; voffB[i] = (unsigned)(Rb * K + C) * 2u; }
    const size_t kstep = (size_t)(BK * 2);
    const size_t hstep = (size_t)HALF * K * 2;
    const size_t tstep = 2 * hstep;
    const unsigned ldsw = (unsigned)wid * 1024u;
    const int aoff = lds_byte(wr * 64 + fr, fq * 8), boff = lds_byte(wc * 32 + fr, fq * 8);
#define PG8_SA(b, h) (((b) * 2 + (h)) * HTB)
#define PG8_SB(b, h) ((4 + (b) * 2 + (h)) * HTB)
#define PG8_STAGE(bufoff, gbase, voff) do { _Pragma("unroll") for (int _i = 0; _i < 2; ++_i) \
        __builtin_amdgcn_global_load_lds((const unsigned*)((const char*)(gbase) + (voff)[_i]), (PG8_LAS unsigned*)(lds + (bufoff) + ldsw + _i * 8192), 16, 0, 0); } while (0)
#define PG8_LDA(dst, b, h) do { _Pragma("unroll") for (int m = 0; m < 4; ++m) _Pragma("unroll") for (int k = 0; k < 2; ++k) dst[m][k] = *(const PG8_LAS bf16x8*)(lds + PG8_SA(b, h) + aoff + m * 2048 + k * 1024); } while (0)
#define PG8_LDB(dst, b, h) do { _Pragma("unroll") for (int n = 0; n < 2; ++n) _Pragma("unroll") for (int k = 0; k < 2; ++k) dst[n][k] = *(const PG8_LAS bf16x8*)(lds + PG8_SB(b, h) + boff + n * 2048 + k * 1024); } while (0)
#define PG8_MMA(ai, bj, At, Bt) do { __builtin_amdgcn_s_setprio(1); _Pragma("unroll") for (int m = 0; m < 4; ++m) _Pragma("unroll") for (int n = 0; n < 2; ++n) _Pragma("unroll") for (int k = 0; k < 2; ++k) \
        acc[ai][bj][m][n] = __builtin_amdgcn_mfma_f32_16x16x32_bf16(Bt[n][k], At[m][k], acc[ai][bj][m][n], 0, 0, 0); __builtin_amdgcn_s_setprio(0); } while (0)
#define PG8_WAIT_V(n) asm volatile("s_waitcnt vmcnt(" #n ")" ::: "memory")
#define PG8_WAIT_L(n) asm volatile("s_waitcnt lgkmcnt(" #n ")" ::: "memory")
#define PG8_BAR __builtin_amdgcn_s_barrier()
#define PG8_SCHED __builtin_amdgcn_sched_barrier(0)
    Unit cur, nxt; int ui = 0;
    if (!S.next(0, cur)) return;
    f32x4 acc[2][2][4][2];
#pragma unroll
    for (int a = 0; a < 2; ++a)
#pragma unroll
        for (int b = 0; b < 2; ++b)
#pragma unroll
            for (int m = 0; m < 4; ++m)
#pragma unroll
                for (int n = 0; n < 2; ++n) acc[a][b][m][n] = (f32x4){0.f, 0.f, 0.f, 0.f};
    bf16x8 At[4][2], B0[2][2], B1[2][2];
    const char* cA = (const char*)g.A + (size_t)cur.pm * tstep; const char* cB = (const char*)g.Bt + (size_t)cur.pn * tstep;
    S.a_ready(cur);
    if constexpr (SP2) {
        PG8_STAGE(PG8_SB(0, 0), cB, voffB); PG8_STAGE(PG8_SB(0, 1), cB + hstep, voffB); PG8_STAGE(PG8_SA(0, 0), cA, voffA); PG8_STAGE(PG8_SA(0, 1), cA + hstep, voffA);
        if (wr == 1) PG8_BAR;
        PG8_WAIT_V(2); PG8_BAR;
        PG8_STAGE(PG8_SB(1, 0), cB + kstep, voffB); PG8_STAGE(PG8_SA(1, 0), cA + kstep, voffA); PG8_STAGE(PG8_SB(1, 1), cB + hstep + kstep, voffB);
        PG8_WAIT_V(6); PG8_BAR;
    } else {
        PG8_STAGE(PG8_SB(0, 0), cB, voffB); PG8_STAGE(PG8_SA(0, 0), cA, voffA); PG8_STAGE(PG8_SB(0, 1), cB + hstep, voffB); PG8_STAGE(PG8_SA(0, 1), cA + hstep, voffA);
        if (wr == 1) PG8_BAR;
        PG8_WAIT_V(4); PG8_BAR;
        PG8_STAGE(PG8_SB(1, 0), cB + kstep, voffB); PG8_STAGE(PG8_SA(1, 0), cA + kstep, voffA); PG8_STAGE(PG8_SB(1, 1), cB + hstep + kstep, voffB);
        PG8_WAIT_V(6); PG8_BAR;
    }
    for (;;) {
        const bool has_next = S.next(ui + 1, nxt);
        const char* nA = has_next ? (const char*)g.A + (size_t)nxt.pm * tstep : cA; const char* nB = has_next ? (const char*)g.Bt + (size_t)nxt.pn * tstep : cB;
#pragma unroll 1
        for (int t = 0; t < nt; t += 2) {
            const bool last = (t == nt - 2);
            const char* a1 = cA + (size_t)(t + 1) * kstep;
            const char* a2 = last ? nA : cA + (size_t)(t + 2) * kstep; const char* b2 = last ? nB : cB + (size_t)(t + 2) * kstep;
            const char* a3 = a2 + kstep; const char* b3 = b2 + kstep;
            if (last && has_next) S.a_ready(nxt);
            if constexpr (SP2) {
            PG8_LDB(B0, 0, 0); PG8_LDB(B1, 0, 1); PG8_SCHED; PG8_LDA(At, 0, 0); PG8_STAGE(PG8_SA(1, 1), a1 + hstep, voffA);
            PG8_WAIT_V(8); PG8_WAIT_L(0); PG8_BAR; PG8_MMA(0, 0, At, B0); PG8_MMA(0, 1, At, B1); PG8_BAR; PG8_SCHED;
            PG8_LDA(At, 0, 1); PG8_STAGE(PG8_SB(0, 0), b2, voffB); PG8_STAGE(PG8_SB(0, 1), b2 + hstep, voffB); PG8_STAGE(PG8_SA(0, 0), a2, voffA);
            PG8_WAIT_V(8); PG8_WAIT_L(0); PG8_BAR; PG8_MMA(1, 0, At, B0); PG8_MMA(1, 1, At, B1); PG8_BAR; PG8_SCHED;
            PG8_LDB(B0, 1, 0); PG8_LDB(B1, 1, 1); PG8_SCHED; PG8_LDA(At, 1, 0); PG8_STAGE(PG8_SA(0, 1), a2 + hstep, voffA);
            PG8_WAIT_V(8); PG8_WAIT_L(0); PG8_BAR; PG8_MMA(0, 0, At, B0); PG8_MMA(0, 1, At, B1); PG8_BAR; PG8_SCHED;
            PG8_LDA(At, 1, 1); PG8_STAGE(PG8_SB(1, 0), b3, voffB); PG8_STAGE(PG8_SB(1, 1), b3 + hstep, voffB); PG8_STAGE(PG8_SA(1, 0), a3, voffA);
            PG8_WAIT_V(8); PG8_WAIT_L(0); PG8_BAR; PG8_MMA(1, 0, At, B0); PG8_MMA(1, 1, At, B1); PG8_BAR; PG8_SCHED;
            } else {
            PG8_LDB(B0, 0, 0); PG8_SCHED; PG8_LDA(At, 0, 0); PG8_STAGE(PG8_SA(1, 1), a1 + hstep, voffA);
            PG8_WAIT_L(8); PG8_BAR; PG8_WAIT_L(0); PG8_MMA(0, 0, At, B0); PG8_BAR; PG8_SCHED;
            PG8_LDB(B1, 0, 1); PG8_STAGE(PG8_SB(0, 0), b2, voffB);
            PG8_BAR; PG8_WAIT_L(0); PG8_MMA(0, 1, At, B1); PG8_BAR;
            PG8_LDA(At, 0, 1); PG8_STAGE(PG8_SA(0, 0), a2, voffA);
            PG8_BAR; PG8_WAIT_L(0); PG8_MMA(1, 0, At, B0); PG8_BAR; PG8_SCHED;
            PG8_STAGE(PG8_SB(0, 1), b2 + hstep, voffB);
            PG8_WAIT_V(6); PG8_BAR; PG8_MMA(1, 1, At, B1); PG8_BAR;
            PG8_LDB(B0, 1, 0); PG8_SCHED; PG8_LDA(At, 1, 0); PG8_STAGE(PG8_SA(0, 1), a2 + hstep, voffA);
            PG8_WAIT_L(8); PG8_BAR; PG8_WAIT_L(0); PG8_MMA(0, 0, At, B0); PG8_BAR; PG8_SCHED;
            PG8_LDB(B1, 1, 1); PG8_STAGE(PG8_SB(1, 0), b3, voffB);
            PG8_BAR; PG8_WAIT_L(0); PG8_MMA(0, 1, At, B1); PG8_BAR;
            PG8_LDA(At, 1, 1); PG8_STAGE(PG8_SA(1, 0), a3, voffA);
            PG8_BAR; PG8_WAIT_L(0); PG8_MMA(1, 0, At, B0); PG8_BAR; PG8_SCHED;
            PG8_STAGE(PG8_SB(1, 1), b3 + hstep, voffB);
            PG8_WAIT_V(6); PG8_BAR; PG8_MMA(1, 1, At, B1); PG8_BAR;
            }
        }
        if constexpr (ALIGN_EPI) { if (wr == 0) PG8_BAR; }
        if constexpr (!Epi::AFTER_DRAIN) { E(acc, cur, wr, wc, fr, fq); S.done(cur); }
        if (!has_next) break;
#pragma unroll
        for (int a = 0; a < 2; ++a)
#pragma unroll
            for (int b = 0; b < 2; ++b)
#pragma unroll
                for (int m = 0; m < 4; ++m)
#pragma unroll
                    for (int n = 0; n < 2; ++n) acc[a][b][m][n] = (f32x4){0.f, 0.f, 0.f, 0.f};
        cur = nxt; cA = nA; cB = nB; ++ui;
        if constexpr (ALIGN_EPI) { if (wr == 1) PG8_BAR; }
    }
    PG8_WAIT_V(0);
    if constexpr (!ALIGN_EPI) { if (wr == 0) PG8_BAR; }
    PG8_BAR;
    if constexpr (Epi::AFTER_DRAIN) { E.fused(acc, cur, wr, wc, fr, fq, lds, wid, lane); S.done(cur); }
#undef PG8_SA
#undef PG8_SB
#undef PG8_STAGE
#undef PG8_LDA
#undef PG8_LDB
#undef PG8_MMA
#undef PG8_WAIT_V
#undef PG8_WAIT_L
#undef PG8_BAR
#undef PG8_SCHED
}
}
namespace att {
constexpr float SCALE = 0.6931471805599453f;
constexpr float THR = 8.f;
constexpr int SHM_V = 16384, SHM_K = 16384;
using bf16 = __hip_bfloat16;
typedef short bf16x8 __attribute__((ext_vector_type(8)));
typedef short s16x4 __attribute__((ext_vector_type(4)));
typedef float f32x16 __attribute__((ext_vector_type(16)));
typedef float f32x4 __attribute__((ext_vector_type(4)));
typedef unsigned u32x4 __attribute__((ext_vector_type(4)));
template <class A, class Bt> struct same_t { static constexpr bool v = false; };
template <class A> struct same_t<A, A> { static constexpr bool v = true; };

#define KSWZ(row, colB) ((row) * 256 + ((colB) ^ (((row) & 7) << 4)))
#define SBAR() __builtin_amdgcn_sched_barrier(0)
__device__ __forceinline__ int v_st(int k, int c) { const int kk = (k & ~0xC) | ((k & 4) << 1) | ((k & 8) >> 1); return ((kk >> 3) * 4 + (c >> 5)) * 512 + ((kk & 7) * 32 + (c & 31)) * 2; }
__device__ __forceinline__ int v_rd_base(int lane) { return ((lane & 3) << 3) | (((lane >> 2) & 3) << 6) | (((lane >> 4) & 1) << 5) | (((lane >> 5) & 1) << 8); }
constexpr int v_rd_off(int d0, int ks, int half) { return d0 * 512 + ks * 4096 + half * 2048; }
__device__ __forceinline__ int crow(int r, int hi) { return (r & 3) + 8 * (r >> 2) + 4 * hi; }
__device__ __forceinline__ unsigned cvtpk(float lo, float hi) {
    unsigned r; asm volatile("v_cvt_pk_bf16_f32 %0, %1, %2" : "=v"(r) : "v"(lo), "v"(hi)); return r;
}
__device__ __forceinline__ bf16x8 pack8(f32x4 a, f32x4 b) {
    u32x4 w = {cvtpk(a[0], a[1]), cvtpk(a[2], a[3]), cvtpk(b[0], b[1]), cvtpk(b[2], b[3])};
    return *reinterpret_cast<bf16x8*>(&w);
}
template <class T> __device__ __forceinline__ bf16x8 load8(const T* p) {
    if constexpr (same_t<T, float>::v) { return pack8(*(const f32x4*)p, *(const f32x4*)(p + 4)); }
    else { return *reinterpret_cast<const bf16x8*>(p); }
}
__device__ __forceinline__ void mask_tile(f32x16& p0, f32x16& p1, int dq, unsigned W) {
    const float NEG = -__builtin_inff();
#pragma unroll
    for (int r = 0; r < 16; ++r) {
        const int c = (r & 3) + 8 * (r >> 2);
        if ((unsigned)(dq - c) >= W) p0[r] = NEG;
        if ((unsigned)(dq - c - 32) >= W) p1[r] = NEG;
    }
}
__device__ __forceinline__ void partialSM(f32x16& p0, f32x16& p1, float& m_reg, float& mn, float& alpha) {
    float pmax = p0[0]; for (int r = 1; r < 16; ++r) pmax = fmaxf(pmax, p0[r]); for (int r = 0; r < 16; ++r) pmax = fmaxf(pmax, p1[r]);
    { auto rr = __builtin_amdgcn_permlane32_swap(__float_as_uint(pmax), __float_as_uint(pmax), false, false);
      pmax = fmaxf(__uint_as_float(rr[0]), __uint_as_float(rr[1])); }
    constexpr float C2 = 1.4426950408889634f * SCALE;
    if (__builtin_expect(__all((pmax - m_reg) * SCALE <= THR), 1)) { mn = m_reg; alpha = 1.f; }
    else { mn = fmaxf(m_reg, pmax); alpha = __builtin_amdgcn_exp2f((m_reg - mn) * C2); m_reg = mn; }
    const float mnL = -mn * C2;
    for (int r = 0; r < 16; ++r) p0[r] = fmaf(p0[r], C2, mnL); for (int r = 0; r < 16; ++r) p1[r] = fmaf(p1[r], C2, mnL);
    for (int r = 0; r < 16; ++r) p0[r] = __builtin_amdgcn_exp2f(p0[r]);
}
__device__ __forceinline__ void finishSM(f32x16& p0, f32x16& p1, float alpha, float& l_reg, bf16x8& pa0, bf16x8& pa1, bf16x8& pa2, bf16x8& pa3) {
    for (int r = 0; r < 16; ++r) p1[r] = __builtin_amdgcn_exp2f(p1[r]);
    float ps = 0; for (int r = 0; r < 16; ++r) ps += p0[r]; for (int r = 0; r < 16; ++r) ps += p1[r];
    { auto rr = __builtin_amdgcn_permlane32_swap(__float_as_uint(ps), __float_as_uint(ps), false, false);
      ps = __uint_as_float(rr[0]) + __uint_as_float(rr[1]); }
    l_reg = l_reg * alpha + ps;
#define PK4(P, B_, OUT) do { unsigned a0 = cvtpk(P[B_+0], P[B_+1]), a1 = cvtpk(P[B_+2], P[B_+3]);                          \
        unsigned b0 = cvtpk(P[B_+4], P[B_+5]), b1 = cvtpk(P[B_+6], P[B_+7]);                                             \
        auto r0 = __builtin_amdgcn_permlane32_swap(a0, b0, false, false); auto r1 = __builtin_amdgcn_permlane32_swap(a1, b1, false, false); \
        u32x4 w = {r0[0], r1[0], r0[1], r1[1]}; OUT = *reinterpret_cast<bf16x8*>(&w); } while (0)
    PK4(p0, 0, pa0); PK4(p0, 8, pa1); PK4(p1, 0, pa2); PK4(p1, 8, pa3);
#undef PK4
}
template <int VB, bool SK>
__device__ __forceinline__ void pv_tile(f32x16* o, int vb0, bf16x8 pa0, bf16x8 pa1, bf16x8 pa2, bf16x8 pa3, bool act) {
    if (SK && !act) return;
#define TRRD(dst, off) asm volatile("ds_read_b64_tr_b16 %0, %1 offset:%2" : "=&v"(dst) : "v"(vb0), "i"(off) : "memory")
#define PV_D0(d0) do { s16x4 l0, l1, l2, l3, h0, h1, h2, h3; constexpr int b_ = VB * SHM_V + v_rd_off(d0, 0, 0);     \
        TRRD(l0, b_); TRRD(h0, b_ + 2048); TRRD(l1, b_ + 4096); TRRD(h1, b_ + 6144); TRRD(l2, b_ + 8192); TRRD(h2, b_ + 10240); TRRD(l3, b_ + 12288); TRRD(h3, b_ + 14336); \
        asm volatile("s_waitcnt lgkmcnt(0)" ::: "memory"); SBAR();                 \
        o[d0] = __builtin_amdgcn_mfma_f32_32x32x16_bf16(pa0, (bf16x8){l0[0], l0[1], l0[2], l0[3], h0[0], h0[1], h0[2], h0[3]}, o[d0], 0, 0, 0);   \
        o[d0] = __builtin_amdgcn_mfma_f32_32x32x16_bf16(pa1, (bf16x8){l1[0], l1[1], l1[2], l1[3], h1[0], h1[1], h1[2], h1[3]}, o[d0], 0, 0, 0);   \
        o[d0] = __builtin_amdgcn_mfma_f32_32x32x16_bf16(pa2, (bf16x8){l2[0], l2[1], l2[2], l2[3], h2[0], h2[1], h2[2], h2[3]}, o[d0], 0, 0, 0);   \
        o[d0] = __builtin_amdgcn_mfma_f32_32x32x16_bf16(pa3, (bf16x8){l3[0], l3[1], l3[2], l3[3], h3[0], h3[1], h3[2], h3[3]}, o[d0], 0, 0, 0); } while (0)
    PV_D0(0); PV_D0(1); PV_D0(2); PV_D0(3);
#undef PV_D0
#undef TRRD
}

template <int VB>
__device__ __forceinline__ void pv_tile2(f32x16* o, int vb0, bf16x8 pa0, bf16x8 pa1, bf16x8 pa2, bf16x8 pa3) {
#define TRRD(dst, off) asm volatile("ds_read_b64_tr_b16 %0, %1 offset:%2" : "=&v"(dst) : "v"(vb0), "i"(off) : "memory")
#define PV_RD(S, d0) do { constexpr int b_ = VB * SHM_V + v_rd_off(d0, 0, 0); \
        TRRD(l0##S, b_); TRRD(h0##S, b_ + 2048); TRRD(l1##S, b_ + 4096); TRRD(h1##S, b_ + 6144); TRRD(l2##S, b_ + 8192); TRRD(h2##S, b_ + 10240); TRRD(l3##S, b_ + 12288); TRRD(h3##S, b_ + 14336); } while (0)
#define PV_MM(S, d0) do { \
        o[d0] = __builtin_amdgcn_mfma_f32_32x32x16_bf16(pa0, (bf16x8){l0##S[0], l0##S[1], l0##S[2], l0##S[3], h0##S[0], h0##S[1], h0##S[2], h0##S[3]}, o[d0], 0, 0, 0);   \
        o[d0] = __builtin_amdgcn_mfma_f32_32x32x16_bf16(pa1, (bf16x8){l1##S[0], l1##S[1], l1##S[2], l1##S[3], h1##S[0], h1##S[1], h1##S[2], h1##S[3]}, o[d0], 0, 0, 0);   \
        o[d0] = __builtin_amdgcn_mfma_f32_32x32x16_bf16(pa2, (bf16x8){l2##S[0], l2##S[1], l2##S[2], l2##S[3], h2##S[0], h2##S[1], h2##S[2], h2##S[3]}, o[d0], 0, 0, 0);   \
        o[d0] = __builtin_amdgcn_mfma_f32_32x32x16_bf16(pa3, (bf16x8){l3##S[0], l3##S[1], l3##S[2], l3##S[3], h3##S[0], h3##S[1], h3##S[2], h3##S[3]}, o[d0], 0, 0, 0); } while (0)
    s16x4 l0a, l1a, l2a, l3a, h0a, h1a, h2a, h3a, l0b, l1b, l2b, l3b, h0b, h1b, h2b, h3b;
    PV_RD(a, 0); PV_RD(b, 1);
    asm volatile("s_waitcnt lgkmcnt(8)" ::: "memory"); SBAR(); PV_MM(a, 0); SBAR();
    PV_RD(a, 2);
    asm volatile("s_waitcnt lgkmcnt(8)" ::: "memory"); SBAR(); PV_MM(b, 1); SBAR();
    PV_RD(b, 3);
    asm volatile("s_waitcnt lgkmcnt(8)" ::: "memory"); SBAR(); PV_MM(a, 2); SBAR();
    asm volatile("s_waitcnt lgkmcnt(0)" ::: "memory"); SBAR(); PV_MM(b, 3);
#undef PV_MM
#undef PV_RD
#undef TRRD
}
template <int KB, bool HALFB>
__device__ __forceinline__ void qkt128(f32x16& p0, f32x16& p1, const char* K_lds, int r32, int hi, const bf16x8* qr, const f32x16& cinit) {
    const char* kb[4];
#pragma unroll
    for (int dd = 0; dd < 4; ++dd) kb[dd] = K_lds + KB * SHM_K + KSWZ(r32, (dd * 16 + hi * 8) * 2) + ((r32 >> 3) & 1) * 128;
    const int kdl = ((r32 >> 3) & 1) ? -128 : 128;
    if (HALFB) {
#pragma unroll
        for (int hb = 0; hb < 2; ++hb) { bf16x8 kf[8];
#pragma unroll
            for (int d = 0; d < 4; ++d) { const int d0 = hb * 4 + d; const char* a = kb[d0 & 3] + (d0 >> 2) * kdl;
                kf[2 * d] = *reinterpret_cast<const bf16x8*>(a); kf[2 * d + 1] = *reinterpret_cast<const bf16x8*>(a + 32 * 256); }
            SBAR();
#pragma unroll
            for (int d = 0; d < 4; ++d) { const int d0 = hb * 4 + d;
                p0 = __builtin_amdgcn_mfma_f32_32x32x16_bf16(kf[2 * d], qr[d0], d0 == 0 ? cinit : p0, 0, 0, 0);
                p1 = __builtin_amdgcn_mfma_f32_32x32x16_bf16(kf[2 * d + 1], qr[d0], d0 == 0 ? cinit : p1, 0, 0, 0); }
            SBAR(); }
    } else {
    bf16x8 kf[16];
#pragma unroll
    for (int d0 = 0; d0 < 8; ++d0) { const char* a = kb[d0 & 3] + (d0 >> 2) * kdl;
        kf[2 * d0] = *reinterpret_cast<const bf16x8*>(a); kf[2 * d0 + 1] = *reinterpret_cast<const bf16x8*>(a + 32 * 256); }
    SBAR();
#pragma unroll
    for (int d0 = 0; d0 < 8; ++d0) {
        p0 = __builtin_amdgcn_mfma_f32_32x32x16_bf16(kf[2 * d0], qr[d0], d0 == 0 ? cinit : p0, 0, 0, 0);
        p1 = __builtin_amdgcn_mfma_f32_32x32x16_bf16(kf[2 * d0 + 1], qr[d0], d0 == 0 ? cinit : p1, 0, 0, 0); }
    }
}
#define KSWZ64(row, colB) ((row) * 128 + ((colB) ^ (((row) & 7) << 4)))
template <int KB>
__device__ __forceinline__ void qkt64(f32x16& p0, f32x16& p1, const char* K_lds, int r32, int hi, const bf16x8* qr, const f32x16& cinit) {
    const int prow = (r32 & ~1) | ((r32 & 1) ^ ((r32 >> 3) & 1));
#pragma unroll
    for (int hb = 0; hb < 2; ++hb) { bf16x8 kf[4];
#pragma unroll
        for (int d = 0; d < 2; ++d) { const int d0 = hb * 2 + d; const char* a = K_lds + KB * SHM_K + prow * 128 + (((d0 * 16 + hi * 8) * 2) ^ ((r32 & 7) << 4));
            kf[2 * d] = *reinterpret_cast<const bf16x8*>(a); kf[2 * d + 1] = *reinterpret_cast<const bf16x8*>(a + 32 * 128); }
        SBAR();
#pragma unroll
        for (int d = 0; d < 2; ++d) { const int d0 = hb * 2 + d;
            p0 = __builtin_amdgcn_mfma_f32_32x32x16_bf16(kf[2 * d], qr[d0], d0 == 0 ? cinit : p0, 0, 0, 0);
            p1 = __builtin_amdgcn_mfma_f32_32x32x16_bf16(kf[2 * d + 1], qr[d0], d0 == 0 ? cinit : p1, 0, 0, 0); }
        SBAR(); }
}
__device__ __forceinline__ void partialSM2(f32x16& p0, f32x16& p1, float& m_ref, f32x16& negm, float& alpha) {
    float pmax = p0[0]; for (int r = 1; r < 16; ++r) pmax = fmaxf(pmax, p0[r]); for (int r = 0; r < 16; ++r) pmax = fmaxf(pmax, p1[r]);
    { auto rr = __builtin_amdgcn_permlane32_swap(__float_as_uint(pmax), __float_as_uint(pmax), false, false);
      pmax = fmaxf(__uint_as_float(rr[0]), __uint_as_float(rr[1])); }
    constexpr float THR2 = THR * 1.4426950408889634f;
    if (__builtin_expect(__all(pmax <= THR2), 1)) { alpha = 1.f; }
    else { const float dl = fmaxf(pmax, 0.f); m_ref += dl; alpha = __builtin_amdgcn_exp2f(-dl);
        for (int r = 0; r < 16; ++r) { p0[r] -= dl; p1[r] -= dl; }
        for (int r = 0; r < 16; ++r) negm[r] = -m_ref; }
    for (int r = 0; r < 16; ++r) p0[r] = __builtin_amdgcn_exp2f(p0[r]);
}
typedef unsigned short bfr;
constexpr int LDS_K = 0, LDS_V = 65536, LDS_WS = 131072, LDS_CK = 131072 + 2048, ATT_LDS = LDS_CK + 768;
struct Unit {
    const bfr* Q; const bfr* K; const bfr* V;
    long stride;
    int q0;
    int j_lo, j_hi;
    int W;
    const float* c;
};
__device__ __forceinline__ void normalize_o(f32x16 (&o)[4], float l_reg, char* lds, int wid, int r32, int hi);
__device__ __forceinline__ float* stage_o(f32x16 (&o)[4], char* lds, int wid, int ln);
#define ATT_LAS __attribute__((address_space(3)))
#ifdef PV_SINGLE
#define PVT(o_, vb_, a0, a1, a2, a3) pv_tile<0, false>(o_, vb_, a0, a1, a2, a3, true)
#else
#define PVT(o_, vb_, a0, a1, a2, a3) pv_tile2<0>(o_, vb_, a0, a1, a2, a3)
#endif
#ifndef NEGM_SEL
#define NEGM_SEL(DQK, FOX, SKIP) (!(FOX))
#endif
template <int DQK, bool FOX, bool SKIP>
__device__ __forceinline__ void unit_core(const Unit& U, char* lds, f32x16 (&o)[4], float& m_reg, float& l_reg,
                                          bf16x8 (&qr)[8], bool have_q, const bfr* nQ, long nstride, int nq0, int nfr) {
    int tid_l = threadIdx.x; asm volatile("" : "+v"(tid_l));
    const int tid = tid_l, wid = __builtin_amdgcn_readfirstlane(tid >> 6), lane = tid & 63, r32 = lane & 31, hi = lane >> 5;
    char* V_lds = lds + LDS_V; char* K_lds = lds + LDS_K;
    ATT_LAS unsigned char* lds3 = (ATT_LAS unsigned char*)(unsigned)(uintptr_t)lds;
    float* ws = (float*)(lds + LDS_WS) + wid * 64; float* al_l = ws + 32;
    float* ckl = (float*)(lds + LDS_CK);
    const int NT = U.j_hi - U.j_lo;
    const int qlo = U.q0 + wid * 32, qm = qlo + r32 - 4 * hi;
    int voff[2];
#pragma unroll
    for (int i = 0; i < 2; ++i) { const int p = (2 * wid + i) * 64 + lane, st = p >> 5, wi = p & 31, kk = (st >> 2) * 8 + (wi >> 2);
        const int key = (kk & ~0xC) | ((kk & 4) << 1) | ((kk & 8) >> 1); voff[i] = key * (int)U.stride + (st & 3) * 32 + (wi & 3) * 8; }
    int koff[2];
    if (DQK == 128) {
#pragma unroll
        for (int i = 0; i < 2; ++i) { const int p = (2 * wid + i) * 64 + lane, row = p >> 4, c = (p & 15) ^ ((row & 7) | (((row >> 3) & 1) << 3)); koff[i] = row * (int)U.stride + c * 8; }
    } else { const int p = wid * 64 + lane, prow = p >> 3, row = (prow & ~1) | ((prow & 1) ^ ((prow >> 3) & 1)), c = (p & 7) ^ (row & 7); koff[0] = row * (int)U.stride + c * 8; koff[1] = 0; }
    const long tstep = 64 * U.stride;
#define A_TIDX(t_) (FOX ? (U.j_hi - 1 - (t_)) : (U.j_lo + (t_)))
#define A_DMA_K(t_, kslot) do { const long tb__ = (long)A_TIDX(t_) * tstep; \
        if (DQK == 128) { _Pragma("unroll") for (int i = 0; i < 2; ++i) \
            __builtin_amdgcn_global_load_lds((const unsigned*)(U.K + tb__ + koff[i]), (ATT_LAS unsigned*)(lds3 + LDS_K + (kslot) * SHM_K + (2 * wid + i) * 1024), 16, 0, 0); } \
        else __builtin_amdgcn_global_load_lds((const unsigned*)(U.K + tb__ + koff[0]), (ATT_LAS unsigned*)(lds3 + LDS_K + (kslot) * SHM_K + wid * 1024), 16, 0, 0); } while (0)
#define A_DMA_V(t_, vslot, cslot) do { const long tb__ = (long)A_TIDX(t_) * tstep; \
        _Pragma("unroll") for (int i = 0; i < 2; ++i) \
            __builtin_amdgcn_global_load_lds((const unsigned*)(U.V + tb__ + voff[i]), (ATT_LAS unsigned*)(lds3 + LDS_V + (vslot) * SHM_V + (2 * wid + i) * 1024), 16, 0, 0); \
        if (FOX) { if (wid == 0) __builtin_amdgcn_global_load_lds((const unsigned*)(U.c + (long)A_TIDX(t_) * 64 + lane), (ATT_LAS unsigned*)(lds3 + LDS_CK + (cslot) * 256), 4, 0, 0); } } while (0)
#define A_DMA_VONLY(t_, vslot) do { const long tb__ = (long)A_TIDX(t_) * tstep; \
        _Pragma("unroll") for (int i = 0; i < 2; ++i) \
            __builtin_amdgcn_global_load_lds((const unsigned*)(U.V + tb__ + voff[i]), (ATT_LAS unsigned*)(lds3 + LDS_V + (vslot) * SHM_V + (2 * wid + i) * 1024), 16, 0, 0); } while (0)
#define A_DMA_CK(t_, cslot) do { if (FOX) { if (wid == 0) __builtin_amdgcn_global_load_lds((const unsigned*)(U.c + (long)A_TIDX(t_) * 64 + lane), (ATT_LAS unsigned*)(lds3 + LDS_CK + (cslot) * 256), 4, 0, 0); } } while (0)
#define A_ISSUE(t_) do { if ((t_) + 3 < NT) A_DMA_K((t_) + 3, (vc + 3) & 3); if ((t_) + 2 < NT) A_DMA_V((t_) + 2, (vc + 2) & 3, A_K2()); } while (0)
#define A_VMW(n) asm volatile("s_waitcnt vmcnt(" #n ") lgkmcnt(0)" ::: "memory")
#define A_WAITBAR(t_) do { const bool ik_ = (t_) + 3 < NT, iv_ = (t_) + 2 < NT; const bool w0_ = FOX && wid == 0; \
        if (ik_) { if (DQK == 128) { if (w0_) A_VMW(5); else A_VMW(4); } else { if (w0_) A_VMW(4); else A_VMW(3); } } \
        else if (iv_) { if (w0_) A_VMW(3); else A_VMW(2); } \
        else A_VMW(0); \
        __builtin_amdgcn_s_barrier(); asm volatile("" ::: "memory"); } while (0)
    if (!have_q) { const bfr* qp = U.Q + (long)(qlo + r32) * U.stride + hi * 8;
#pragma unroll
      for (int d0 = 0; d0 < DQK / 16; ++d0) qr[d0] = *reinterpret_cast<const bf16x8*>(qp + d0 * 16); }
    if (SKIP) { A_DMA_K(0, 0); A_DMA_VONLY(0, 0); } else { A_DMA_CK(0, 0); A_DMA_K(0, 0); A_DMA_VONLY(0, 0); }
    if (NT > 1) { A_DMA_K(1, 1); A_DMA_V(1, 1, 1); } if (NT > 2) A_DMA_K(2, 2);
#define A_QPF() do { if (nfr) { const bfr* qp_ = nQ + (long)(nq0 + wid * 32 + r32) * nstride + hi * 8; \
        _Pragma("unroll") for (int d0 = 0; d0 < 8; ++d0) { if (d0 < nfr) qr[d0] = *reinterpret_cast<const bf16x8*>(qp_ + d0 * 16); } } } while (0)
    float cqv = 0.f; if (FOX) cqv = U.c[qlo + r32];
    constexpr bool NEGM = NEGM_SEL(DQK, FOX, SKIP);
    m_reg = !NEGM ? -1e30f : 0.f; l_reg = 0.f;
    f32x16 negm = f32x16{};
#pragma unroll
    for (int d = 0; d < 4; ++d) o[d] = f32x16{};
    const int vb0 = (int)(uintptr_t)V_lds + v_rd_base(lane);
    { const bool w0_ = FOX && wid == 0;
      if (SKIP) { if (NT > 2) A_VMW(6); else if (NT > 1) A_VMW(4); else A_VMW(0); }
      else if (DQK == 128) { if (NT > 2) { if (w0_) A_VMW(9); else A_VMW(8); } else if (NT > 1) { if (w0_) A_VMW(7); else A_VMW(6); } else A_VMW(2); }
      else { if (NT > 2) A_VMW(6); else if (NT > 1) A_VMW(5); else A_VMW(2); }
      __builtin_amdgcn_s_barrier(); asm volatile("" ::: "memory"); }
    f32x16 pA0, pA1, pB0, pB1; bf16x8 pa0, pa1, pa2, pa3; float mnA = 0.f, mnB = 0.f, alA = 1.f, alB = 1.f; bool actA = false, actB = false;
    int kc = 0, vc = 0;
#define A_ACT(t_) (!SKIP || (((A_TIDX(t_) * 64 <= qlo + 31) && (A_TIDX(t_) * 64 + 63 + U.W > qlo))))
#define A_HEADS(PX0, PX1, mnX, alX, actX, t_, ks_) do { actX = A_ACT(t_); alX = 1.f; \
        if (!SKIP || actX) { \
            if (DQK == 128) qkt128<0, true>(PX0, PX1, K_lds + (ks_) * SHM_K, r32, hi, qr, negm); else qkt64<0>(PX0, PX1, K_lds + (ks_) * SHM_K, r32, hi, qr, negm); } } while (0)
#define A_HEAD(PX0, PX1, mnX, alX, actX, t_) A_HEADS(PX0, PX1, mnX, alX, actX, t_, vc)
#define A_SOFT1(PX0, PX1, mnX, alX, actX, t_) do { const int kb_ = A_TIDX(t_) * 64; \
        if (!SKIP || actX) { \
            if (FOX) { const float* ck_ = ckl + kc * 64 + 4 * hi; \
                _Pragma("unroll") for (int g = 0; g < 4; ++g) { const f32x4 c0 = *(const f32x4*)(ck_ + 8 * g); const f32x4 c1 = *(const f32x4*)(ck_ + 32 + 8 * g); \
                    _Pragma("unroll") for (int i = 0; i < 4; ++i) { PX0[4 * g + i] += cqv - c0[i]; PX1[4 * g + i] += cqv - c1[i]; } } } \
            if (kb_ + 63 > qlo || kb_ + U.W <= qlo + 31) mask_tile(PX0, PX1, qm - kb_, (unsigned)U.W); \
            if (!NEGM) partialSM(PX0, PX1, m_reg, mnX, alX); else partialSM2(PX0, PX1, m_reg, negm, alX); } } while (0)
#define A_TAIL(PY0, PY1, alY, actY, vslot) do { if (!SKIP || actY) { finishSM(PY0, PY1, alY, l_reg, pa0, pa1, pa2, pa3); SBAR(); PVT(o, vb0 + (vslot) * SHM_V, pa0, pa1, pa2, pa3); } } while (0)
#define A_RESC(alX) do { if (__any((alX) < 1.f)) { if (hi == 0) al_l[r32] = (alX); asm volatile("s_waitcnt lgkmcnt(0)" ::: "memory"); \
        _Pragma("unroll") for (int d_ = 0; d_ < 4; ++d_) _Pragma("unroll") for (int r = 0; r < 16; ++r) o[d_][r] *= al_l[crow(r, hi)]; } } while (0)
#define A_ROT() do { kc = (kc == 2) ? 0 : kc + 1; vc = (vc + 1) & 3; } while (0)
#define A_K2() ((kc == 0) ? 2 : kc - 1)
    if (SKIP) {
        for (int ts = 0; ts < NT; ++ts) {
            A_ISSUE(ts);
            if (A_ACT(ts)) { actA = true; A_HEAD(pA0, pA1, mnA, alA, actA, ts); A_SOFT1(pA0, pA1, mnA, alA, actA, ts); A_RESC(alA);
                finishSM(pA0, pA1, alA, l_reg, pa0, pa1, pa2, pa3); SBAR(); PVT(o, vb0 + vc * SHM_V, pa0, pa1, pa2, pa3); }
            A_WAITBAR(ts); A_ROT(); }
        A_QPF();
        normalize_o(o, l_reg, lds, wid, r32, hi); { int ln_ = lane; asm volatile("" : "+v"(ln_)); stage_o(o, lds, wid, ln_); }
        return;
    }
#define A_STEP_AB(PX0, PX1, mnX, alX, actX, PY0, PY1, mnY, alY, actY, t_) do { const int t__ = (t_); \
        A_ISSUE(t__); \
        SBAR(); if (grpA) { A_HEAD(PX0, PX1, mnX, alX, actX, t__); } SBAR(); \
        A_TAIL(PY0, PY1, alY, actY, (vc + 3) & 3); \
        A_SOFT1(PX0, PX1, mnX, alX, actX, t__); \
        A_RESC(alX); SBAR(); \
        if (!grpA && t__ + 1 < NT) { A_HEADS(PY0, PY1, mnY, alY, actY, t__ + 1, (vc + 1) & 3); } \
        A_WAITBAR(t__); A_ROT(); } while (0)
#define A_LOOP(STEPM) do { int t = 1; \
        for (; t + 1 < NT; t += 2) { \
            STEPM(pB0, pB1, mnB, alB, actB, pA0, pA1, mnA, alA, actA, t); \
            STEPM(pA0, pA1, mnA, alA, actA, pB0, pB1, mnB, alB, actB, t + 1); } \
        if (t < NT) { STEPM(pB0, pB1, mnB, alB, actB, pA0, pA1, mnA, alA, actA, t); pA0 = pB0; pA1 = pB1; alA = alB; actA = actB; } \
        A_QPF(); A_TAIL(pA0, pA1, alA, actA, (vc + 3) & 3); } while (0)
#define A_FIN() do { asm volatile("s_waitcnt lgkmcnt(0)" ::: "memory"); __builtin_amdgcn_s_barrier(); asm volatile("" ::: "memory"); \
        normalize_o(o, l_reg, lds, wid, r32, hi); { int ln_ = lane; asm volatile("" : "+v"(ln_)); stage_o(o, lds, wid, ln_); } } while (0)
    const bool grpA = true;
    { A_ISSUE(0);
      A_HEAD(pA0, pA1, mnA, alA, actA, 0); A_SOFT1(pA0, pA1, mnA, alA, actA, 0); SBAR();
      if (!grpA && NT > 1) { A_HEADS(pB0, pB1, mnB, alB, actB, 1, 1); }
      A_WAITBAR(0); A_ROT(); }
    A_LOOP(A_STEP_AB); A_FIN();
    return;
#undef A_FIN
#undef A_QPF
#undef A_LOOP
#undef A_STEP_AB
#undef A_K2
#undef A_ROT
#undef A_RESC
#undef A_TAIL
#undef A_SOFT1
#undef A_HEAD
#undef A_HEADS
#undef A_ACT
#undef A_WAITBAR
#undef A_ISSUE
#undef A_TIDX
#undef A_DMA_K
#undef A_DMA_V
#undef A_DMA_VONLY
#undef A_DMA_CK
#undef A_VMW
}
__device__ __forceinline__ void normalize_o(f32x16 (&o)[4], float l_reg, char* lds, int wid, int r32, int hi) {
    float* li_l = (float*)(lds + LDS_WS) + wid * 64;
    if (hi == 0) li_l[r32] = l_reg; asm volatile("s_waitcnt lgkmcnt(0)" ::: "memory");
#pragma unroll
    for (int r = 0; r < 16; ++r) { const float rl = __builtin_amdgcn_rcpf(li_l[crow(r, hi)]);
#pragma unroll
        for (int d = 0; d < 4; ++d) o[d][r] *= rl; }
    asm volatile("s_waitcnt lgkmcnt(0)" ::: "memory");
}
__device__ __forceinline__ float* stage_o(f32x16 (&o)[4], char* lds, int wid, int ln) {
    float* stg = (float*)(lds + wid * 16384);
    float* wb = stg + (ln >> 5) * 512 + (ln & 31);
#pragma unroll
    for (int r = 0; r < 16; ++r)
#pragma unroll
        for (int d0 = 0; d0 < 4; ++d0) wb[((r & 3) + 8 * (r >> 2)) * 128 + d0 * 32] = o[d0][r];
    asm volatile("s_waitcnt lgkmcnt(0)" ::: "memory");
    return stg;
}
__device__ __forceinline__ f32x4 stg_chunk(const float* stg, int row, int half, int j) { return *(const f32x4*)(stg + row * 128 + half * 64 + 4 * j); }
}
constexpr int BATCH = 8, SEQ = 4096, DM = 1024, TOK = BATCH * SEQ, PLE = 256, EVEN_IN = 4100, NPROJ = 4096;
constexpr float RMS_EPS = 1e-6f, LAM_INIT0 = 0.2f;
constexpr size_t MiB = 1u << 20;
constexpr size_t WS_RSTD0 = 0, WS_LF = 256 * 1024, WS_C = 1 * MiB, WS_SSQ = 2 * MiB, WS_LSE = 4 * MiB, WS_BAR = 7 * MiB, BAR_BYTES = 16384;
constexpr size_t WS_W0T = 8 * MiB, WS_W1T = 16 * MiB, WS_WO0T = 24 * MiB, WS_WO1T = 26 * MiB, WS_WG0T = 28 * MiB, WS_WG1T = 30 * MiB, WS_WP0T = 32 * MiB, WS_WP1T = 32 * MiB + 512 * 1024;
constexpr size_t WS_PB = 34 * MiB, WS_A = 50 * MiB, WS_B = 114 * MiB, WS_CC = 178 * MiB, WS_PROJ = 242 * MiB, WS_ROPE = 498 * MiB, WS_END = 502 * MiB;
constexpr int LDS_BYTES = 147456, LDS_XCH = 135168;
typedef unsigned short bfr;
typedef float f32x4 __attribute__((ext_vector_type(4)));
typedef unsigned u32x4 __attribute__((ext_vector_type(4)));
typedef unsigned u32x2 __attribute__((ext_vector_type(2)));

struct Params {
    const float* x; const float* p; const int* positions; const float* norm_g; const float* w_in_even; const float* b_forget;
    const float* qn_a; const float* kn_a; const float* qn_b; const float* kn_b; const float* lam_q1; const float* lam_k1; const float* lam_q2; const float* lam_k2;
    const float* subln_g; const float* w_out_even; const float* w_in_odd; const float* qn_c; const float* kn_c; const float* w_out_odd; const float* w_ple; const float* w_ple_gate;
    float* out; unsigned char* ws;
};

__device__ __forceinline__ unsigned cvtpk(float lo, float hi) { unsigned r; asm volatile("v_cvt_pk_bf16_f32 %0, %1, %2" : "=v"(r) : "v"(lo), "v"(hi)); return r; }
__device__ __forceinline__ float bf2f(unsigned short b) { return __uint_as_float((unsigned)b << 16); }
__device__ __forceinline__ float shx(float v, int mask, int ln) { return __int_as_float(__builtin_amdgcn_ds_bpermute((ln ^ mask) << 2, __float_as_int(v))); }
__device__ __forceinline__ float wave_sum(float v, int ln) {
#pragma unroll
    for (int o = 1; o < 64; o <<= 1) v += shx(v, o, ln);
    return v;
}
__device__ __forceinline__ float silu_f(float z) { return z / (1.f + __expf(-z)); }
#ifdef V_FASTSIG
__device__ __forceinline__ float sigmoid_f(float z) { return __builtin_amdgcn_rcpf(1.f + __builtin_amdgcn_exp2f(-1.4426950408889634f * z)); }
#else
__device__ __forceinline__ float sigmoid_f(float z) { return 1.f / (1.f + __expf(-z)); }
#endif

struct EpiProj {
    static constexpr bool PERM = true, AFTER_DRAIN = false;
    bfr* O; int ldc; const float* rstd; const float* ssqp;
    __device__ __forceinline__ void operator()(const pg8::f32x4 (&acc)[2][2][4][2], const pg8::Unit& u, int wr, int wc, int fr, int fq) const {
        int fr_ = fr, fq_ = fq; asm volatile("" : "+v"(fr_), "+v"(fq_));
        const int row0 = u.pm * 256 + wr * 64 + fr_;
        bfr* Ob = O + (size_t)u.pm * 256 * ldc + u.pn * 256; const unsigned loff = (unsigned)(wr * 64 + fr_) * (unsigned)ldc + (unsigned)(wc * 32 + 8 * fq_);
#pragma unroll
        for (int ai = 0; ai < 2; ++ai)
#pragma unroll
            for (int m = 0; m < 4; ++m) { const int row = row0 + ai * 128 + m * 16; float rs;
                if (ssqp) { const f32x4* sp = (const f32x4*)(ssqp + (unsigned)row * 16u); const f32x4 a = sp[0], b = sp[1], c = sp[2], d = sp[3];
                    const float s = ((a[0] + a[1]) + (a[2] + a[3])) + ((b[0] + b[1]) + (b[2] + b[3])) + ((c[0] + c[1]) + (c[2] + c[3])) + ((d[0] + d[1]) + (d[2] + d[3]));
                    rs = __builtin_amdgcn_rsqf(s * (1.f / 1024.f) + RMS_EPS); }
                else rs = rstd[row];
                bfr* rowp = Ob + (loff + (unsigned)(ai * 128 + m * 16) * (unsigned)ldc);
#pragma unroll
                for (int bj = 0; bj < 2; ++bj) { const pg8::f32x4 v0 = acc[ai][bj][m][0] * rs, v1 = acc[ai][bj][m][1] * rs;
                    u32x4 w; w.x = cvtpk(v0[0], v0[1]); w.y = cvtpk(v0[2], v0[3]); w.z = cvtpk(v1[0], v1[1]); w.w = cvtpk(v1[2], v1[3]);
                    *(u32x4*)(rowp + bj * 128) = w; }
                asm volatile("" ::: "memory"); }
    }
};
template <int LAYER>
struct EpiProjNR {
    static constexpr bool PERM = true, AFTER_DRAIN = false;
    bfr* O; const float* rstd; const float* ssqp; const float* rope; const float* g_q64; const float* g_k64; const float* g_q128; const float* g_k128; float* xch;
    __device__ __forceinline__ void operator()(const pg8::f32x4 (&acc)[2][2][4][2], const pg8::Unit& u, int wr, int wc, int fr, int fq) const {
        int fr_ = fr, fq_ = fq; asm volatile("" : "+v"(fr_), "+v"(fq_));
        const int ln = fq_ * 16 + fr_, rl0 = wr * 64 + fr_, row0 = u.pm * 256 + rl0;
        int gw = 0; const float* gain = nullptr; float scale = 1.f; bool rope_t = false;
        if (LAYER == 0) {
            if (u.pn < 2) { gw = 64; gain = g_q64; scale = 0.125f * 1.4426950408889634f; rope_t = true; }
            else if (u.pn < 4) { gw = 64; gain = g_k64; rope_t = true; }
            else if (u.pn == 6 || u.pn == 7) { gw = 128; gain = g_q128; scale = 0.08838834764831845f * 1.4426950408889634f; }
            else if (u.pn == 8 || u.pn == 9) { gw = 128; gain = g_k128; }
        } else {
            if (u.pn < 4) { gw = 128; gain = g_q128; scale = 0.08838834764831845f * 1.4426950408889634f; rope_t = true; }
            else if (u.pn < 8) { gw = 128; gain = g_k128; rope_t = true; }
        }
        bfr* Ob = O + (size_t)u.pm * 256 * NPROJ + u.pn * 256; const unsigned loff = (unsigned)rl0 * (unsigned)NPROJ + (unsigned)(wc * 32 + 8 * fq_);
        float rs[8];
#pragma unroll
        for (int ai = 0; ai < 2; ++ai) {
            if (ssqp) { f32x4 pv[4][4];
#pragma unroll
                for (int m = 0; m < 4; ++m) { const f32x4* sp = (const f32x4*)(ssqp + (unsigned)(row0 + ai * 128 + m * 16) * 16u); pv[m][0] = sp[0]; pv[m][1] = sp[1]; pv[m][2] = sp[2]; pv[m][3] = sp[3]; }
#pragma unroll
                for (int m = 0; m < 4; ++m) { const f32x4 a = pv[m][0], b = pv[m][1], c = pv[m][2], d = pv[m][3];
                    const float sm = ((a[0] + a[1]) + (a[2] + a[3])) + ((b[0] + b[1]) + (b[2] + b[3])) + ((c[0] + c[1]) + (c[2] + c[3])) + ((d[0] + d[1]) + (d[2] + d[3]));
                    rs[ai * 4 + m] = __builtin_amdgcn_rsqf(sm * (1.f / 1024.f) + RMS_EPS); } }
            else {
#pragma unroll
                for (int m = 0; m < 4; ++m) rs[ai * 4 + m] = rstd[row0 + ai * 128 + m * 16]; }
            asm volatile("" ::: "memory"); }
        if (gw == 0) {
#pragma unroll
            for (int ai = 0; ai < 2; ++ai)
#pragma unroll
                for (int m = 0; m < 4; ++m) { bfr* rowp = Ob + (loff + (unsigned)(ai * 128 + m * 16) * (unsigned)NPROJ); const float r = rs[ai * 4 + m];
#pragma unroll
                    for (int bj = 0; bj < 2; ++bj) { const pg8::f32x4 v0 = acc[ai][bj][m][0] * r, v1 = acc[ai][bj][m][1] * r;
                        u32x4 w; w.x = cvtpk(v0[0], v0[1]); w.y = cvtpk(v0[2], v0[3]); w.z = cvtpk(v1[0], v1[1]); w.w = cvtpk(v1[2], v1[3]);
                        *(u32x4*)(rowp + bj * 128) = w; } }
            return;
        }
#pragma unroll
        for (int ai = 0; ai < 2; ++ai)
#pragma unroll
            for (int m = 0; m < 4; ++m) { const float r = rs[ai * 4 + m];
#pragma unroll
                for (int bj = 0; bj < 2; ++bj) { const pg8::f32x4 v0 = acc[ai][bj][m][0] * r, v1 = acc[ai][bj][m][1] * r;
                    float ss = (v0[0] * v0[0] + v0[1] * v0[1]) + (v0[2] * v0[2] + v0[3] * v0[3]) + (v1[0] * v1[0] + v1[1] * v1[1]) + (v1[2] * v1[2] + v1[3] * v1[3]);
                    ss += shx(ss, 16, ln); ss += shx(ss, 32, ln);
                    if (fq_ == 0) xch[(rl0 + ai * 128 + m * 16) * 8 + bj * 4 + wc] = ss; } }
        asm volatile("s_waitcnt lgkmcnt(0)" ::: "memory"); __builtin_amdgcn_s_barrier(); asm volatile("" ::: "memory");
        const int cig = (gw == 128) ? (wc * 32 + 8 * fq_) : ((wc & 1) * 32 + 8 * fq_);
        float gn[8];
        { const f32x4 ga = *(const f32x4*)(gain + cig), gb = *(const f32x4*)(gain + cig + 4); gn[0] = ga[0]; gn[1] = ga[1]; gn[2] = ga[2]; gn[3] = ga[3]; gn[4] = gb[0]; gn[5] = gb[1]; gn[6] = gb[2]; gn[7] = gb[3]; }
        const bool rope_w = rope_t && ((gw == 128) ? (wc == 0) : ((wc & 1) == 0));
        const bool rope_l = (gw == 128) ? true : (fq_ < 2);
        const bool isx2 = (gw == 128) ? (fq_ >= 2) : (fq_ == 1);
        const int pd = (gw == 128) ? 32 : 16;
        const float inv_gw = (gw == 128) ? (1.f / 128.f) : (1.f / 64.f);
#pragma unroll
        for (int ap = 0; ap < 4; ++ap) { const int ai = ap >> 1, mb = (ap & 1) * 2;
            float cs[2][8], sn[2][8];
            if (rope_w) {
#pragma unroll
                for (int mm = 0; mm < 2; ++mm) { const int m = mm; const float* tb = rope + (size_t)(u.pm * 256 + rl0 + ai * 128 + (mb + mm) * 16) * 32;
                    if (gw == 128) { const int ib = (fq_ & 1) * 8; const f32x4 c0 = *(const f32x4*)(tb + ib), c1 = *(const f32x4*)(tb + ib + 4), s0 = *(const f32x4*)(tb + 16 + ib), s1 = *(const f32x4*)(tb + 16 + ib + 4);
#pragma unroll
                        for (int j = 0; j < 4; ++j) { cs[m][j] = c0[j]; cs[m][4 + j] = c1[j]; sn[m][j] = s0[j]; sn[m][4 + j] = s1[j]; } }
                    else { const f32x4 c0 = *(const f32x4*)(tb), c1 = *(const f32x4*)(tb + 4), c2 = *(const f32x4*)(tb + 8), c3 = *(const f32x4*)(tb + 12);
                        const f32x4 s0 = *(const f32x4*)(tb + 16), s1 = *(const f32x4*)(tb + 20), s2 = *(const f32x4*)(tb + 24), s3 = *(const f32x4*)(tb + 28);
                        cs[m][0] = c0[0]; cs[m][1] = c0[2]; cs[m][2] = c1[0]; cs[m][3] = c1[2]; cs[m][4] = c2[0]; cs[m][5] = c2[2]; cs[m][6] = c3[0]; cs[m][7] = c3[2];
                        sn[m][0] = s0[0]; sn[m][1] = s0[2]; sn[m][2] = s1[0]; sn[m][3] = s1[2]; sn[m][4] = s2[0]; sn[m][5] = s2[2]; sn[m][6] = s3[0]; sn[m][7] = s3[2]; } } }
#pragma unroll
            for (int mm = 0; mm < 2; ++mm) { const int m = mb + mm; const int rl = rl0 + ai * 128 + m * 16; const float r = rs[ai * 4 + m];
#pragma unroll
                for (int bj = 0; bj < 2; ++bj) {
                    float sq;
                    if (gw == 128) { const f32x4 x = *(const f32x4*)(xch + rl * 8 + bj * 4); sq = (x[0] + x[1]) + (x[2] + x[3]); }
                    else { const float* xp = xch + rl * 8 + bj * 4 + (wc & 2); sq = xp[0] + xp[1]; }
                    const float f = r * __builtin_amdgcn_rsqf(sq * inv_gw + RMS_EPS);
                    float v[8];
#pragma unroll
                    for (int j = 0; j < 4; ++j) { v[j] = acc[ai][bj][m][0][j] * f * gn[j]; v[4 + j] = acc[ai][bj][m][1][j] * f * gn[4 + j]; }
                    if (rope_w) { float pr[8];
#pragma unroll
                        for (int j = 0; j < 8; ++j) pr[j] = shx(v[j], pd, ln);
                        if (rope_l) {
#pragma unroll
                            for (int j = 0; j < 8; ++j) v[j] = isx2 ? (v[j] * cs[mm][j] + pr[j] * sn[mm][j]) : (v[j] * cs[mm][j] - pr[j] * sn[mm][j]); } }
                    u32x4 w; w.x = cvtpk(v[0] * scale, v[1] * scale); w.y = cvtpk(v[2] * scale, v[3] * scale); w.z = cvtpk(v[4] * scale, v[5] * scale); w.w = cvtpk(v[6] * scale, v[7] * scale);
                    *(u32x4*)(Ob + (loff + (unsigned)(ai * 128 + m * 16) * (unsigned)NPROJ) + bj * 128) = w; } }
            asm volatile("" ::: "memory"); }
    }
};
template <bool BASE_BF16>
struct EpiRes {
    static constexpr bool PERM = true, AFTER_DRAIN = false;
    const float* basef; const bfr* baseh; bfr* hb;
    __device__ __forceinline__ void operator()(const pg8::f32x4 (&acc)[2][2][4][2], const pg8::Unit& u, int wr, int wc, int fr, int fq) const {
        int fr_ = fr, fq_ = fq; asm volatile("" : "+v"(fr_), "+v"(fq_));
        const size_t ub = (size_t)u.pm * 256 * DM + u.pn * 256; const float* bfb = basef + ub; const bfr* bhb = baseh + ub; bfr* hbb = hb + ub;
        const unsigned loff = (unsigned)(wr * 64 + fr_) * DM + (unsigned)(wc * 32 + 8 * fq_);
#pragma unroll
        for (int ai = 0; ai < 2; ++ai)
#pragma unroll
            for (int m = 0; m < 4; ++m) { const unsigned off = loff + (unsigned)(ai * 128 + m * 16) * DM;
#pragma unroll
                for (int bj = 0; bj < 2; ++bj) { const unsigned o2 = off + bj * 128; f32x4 b0, b1;
                    if (BASE_BF16) { const u32x4 bw = *(const u32x4*)(bhb + o2);
                        b0[0] = __uint_as_float(bw.x << 16); b0[1] = __uint_as_float(bw.x & 0xffff0000u); b0[2] = __uint_as_float(bw.y << 16); b0[3] = __uint_as_float(bw.y & 0xffff0000u);
                        b1[0] = __uint_as_float(bw.z << 16); b1[1] = __uint_as_float(bw.z & 0xffff0000u); b1[2] = __uint_as_float(bw.w << 16); b1[3] = __uint_as_float(bw.w & 0xffff0000u); }
                    else { b0 = *(const f32x4*)(bfb + o2); b1 = *(const f32x4*)(bfb + o2 + 4); }
                    const f32x4 v0 = b0 + acc[ai][bj][m][0], v1 = b1 + acc[ai][bj][m][1];
                    u32x4 w; w.x = cvtpk(v0[0], v0[1]); w.y = cvtpk(v0[2], v0[3]); w.z = cvtpk(v1[0], v1[1]); w.w = cvtpk(v1[2], v1[3]);
                    *(u32x4*)(hbb + o2) = w; }
                asm volatile("" ::: "memory"); }
    }
};
struct EpiT1 {
    static constexpr bool PERM = true, AFTER_DRAIN = false;
    bfr* t1;
    __device__ __forceinline__ void operator()(const pg8::f32x4 (&acc)[2][2][4][2], const pg8::Unit& u, int wr, int wc, int fr, int fq) const {
        int fr_ = fr, fq_ = fq; asm volatile("" : "+v"(fr_), "+v"(fq_));
        bfr* tb = t1 + (size_t)u.pm * 256 * DM + u.pn * 256; const unsigned loff = (unsigned)(wr * 64 + fr_) * DM + (unsigned)(wc * 32 + 8 * fq_);
#pragma unroll
        for (int ai = 0; ai < 2; ++ai)
#pragma unroll
            for (int m = 0; m < 4; ++m) { const unsigned off = loff + (unsigned)(ai * 128 + m * 16) * DM;
#pragma unroll
                for (int bj = 0; bj < 2; ++bj) { const pg8::f32x4 v0 = acc[ai][bj][m][0], v1 = acc[ai][bj][m][1];
                    u32x4 w; w.x = cvtpk(v0[0], v0[1]); w.y = cvtpk(v0[2], v0[3]); w.z = cvtpk(v1[0], v1[1]); w.w = cvtpk(v1[2], v1[3]);
                    *(u32x4*)(tb + off + bj * 128) = w; }
                asm volatile("" ::: "memory"); }
    }
};
struct EpiGate {
    static constexpr bool PERM = true, AFTER_DRAIN = false;
    const bfr* hin; const bfr* t1; bfr* hb2; float* ssqp; float* fout;
    __device__ __forceinline__ void operator()(const pg8::f32x4 (&acc)[2][2][4][2], const pg8::Unit& u, int wr, int wc, int fr, int fq) const {
        int fr_ = fr, fq_ = fq; asm volatile("" : "+v"(fr_), "+v"(fq_));
        const int row0 = u.pm * 256 + wr * 64 + fr_;
        const size_t ub = (size_t)u.pm * 256 * DM + u.pn * 256; const bfr* hbp = hin + ub; const bfr* t1b = t1 + ub; bfr* hb2b = hb2 ? hb2 + ub : nullptr; float* fo = fout ? fout + ub : nullptr;
        const unsigned loff = (unsigned)(wr * 64 + fr_) * DM + (unsigned)(wc * 32 + 8 * fq_);
#pragma unroll
        for (int ai = 0; ai < 2; ++ai)
#pragma unroll
            for (int m = 0; m < 4; ++m) { const int row = row0 + ai * 128 + m * 16; const unsigned off = loff + (unsigned)(ai * 128 + m * 16) * DM; float ss = 0.f;
#pragma unroll
                for (int bj = 0; bj < 2; ++bj) { const unsigned o2 = off + bj * 128;
                    const u32x4 bw = *(const u32x4*)(hbp + o2); const u32x4 tw = *(const u32x4*)(t1b + o2);
                    const float bb[8] = {__uint_as_float(bw.x << 16), __uint_as_float(bw.x & 0xffff0000u), __uint_as_float(bw.y << 16), __uint_as_float(bw.y & 0xffff0000u),
                                         __uint_as_float(bw.z << 16), __uint_as_float(bw.z & 0xffff0000u), __uint_as_float(bw.w << 16), __uint_as_float(bw.w & 0xffff0000u)};
                    const float tt[8] = {__uint_as_float(tw.x << 16), __uint_as_float(tw.x & 0xffff0000u), __uint_as_float(tw.y << 16), __uint_as_float(tw.y & 0xffff0000u),
                                         __uint_as_float(tw.z << 16), __uint_as_float(tw.z & 0xffff0000u), __uint_as_float(tw.w << 16), __uint_as_float(tw.w & 0xffff0000u)};
                    f32x4 v0, v1;
#pragma unroll
                    for (int i = 0; i < 4; ++i) { v0[i] = bb[i] + tt[i] * sigmoid_f(acc[ai][bj][m][0][i]); v1[i] = bb[4 + i] + tt[4 + i] * sigmoid_f(acc[ai][bj][m][1][i]); }
                    if (fout) { __builtin_nontemporal_store(v0, (f32x4*)(fo + o2)); __builtin_nontemporal_store(v1, (f32x4*)(fo + o2 + 4)); }
                    if (hb2) { u32x4 w; w.x = cvtpk(v0[0], v0[1]); w.y = cvtpk(v0[2], v0[3]); w.z = cvtpk(v1[0], v1[1]); w.w = cvtpk(v1[2], v1[3]); *(u32x4*)(hb2b + o2) = w; }
                    ss += (v0[0] * v0[0] + v0[1] * v0[1]) + (v0[2] * v0[2] + v0[3] * v0[3]) + (v1[0] * v1[0] + v1[1] * v1[1]) + (v1[2] * v1[2] + v1[3] * v1[3]); }
                if (ssqp) { const int ln_ = fq_ * 16 + fr_;
                    ss += __int_as_float(__builtin_amdgcn_ds_bpermute((ln_ ^ 16) << 2, __float_as_int(ss))); ss += __int_as_float(__builtin_amdgcn_ds_bpermute((ln_ ^ 32) << 2, __float_as_int(ss))); if (fq_ == 0) ssqp[(unsigned)row * 16u + (unsigned)(u.pn * 4 + wc)] = ss; }
                asm volatile("" ::: "memory"); }
    }
};

__device__ __forceinline__ void transpose_item(const float* W, int ldw, int csrc, int K, int ncols, const float* g, bfr* WT, int row_off, float* scr, int item, int lane) {
    const int nblk = ncols / 32, kb = item / nblk, nb = item % nblk, k0 = 64 * kb, n0 = 32 * nb;
#pragma unroll 8
    for (int i = 0; i < 32; ++i) { const int kk = 2 * i + (lane >> 5); float v = __builtin_nontemporal_load(W + (size_t)(k0 + kk) * ldw + csrc + n0 + (lane & 31)); if (g) v *= g[k0 + kk]; scr[kk * 33 + (lane & 31)] = v; }
    asm volatile("s_waitcnt lgkmcnt(0)" ::: "memory");
    const int c = lane & 7;
#pragma unroll
    for (int j = 0; j < 4; ++j) { const int n = (lane >> 3) + 8 * j; const float* s = scr + (8 * c) * 33 + n;
        u32x4 o; o.x = cvtpk(s[0 * 33], s[1 * 33]); o.y = cvtpk(s[2 * 33], s[3 * 33]); o.z = cvtpk(s[4 * 33], s[5 * 33]); o.w = cvtpk(s[6 * 33], s[7 * 33]);
        *(u32x4*)(WT + (size_t)(row_off + n0 + n) * K + k0 + 8 * c) = o; }
    asm volatile("s_waitcnt lgkmcnt(0)" ::: "memory");
}

__device__ __forceinline__ void phase_prologue(const Params& P, char* lds, int G, int blk) {
    unsigned char* ws = P.ws;
    int tid_l = threadIdx.x; asm volatile("" : "+v"(tid_l));
    const int tid = tid_l, lane = tid & 63, wave = tid >> 6;
    const int gw = blk * 8 + wave, NGW = G * 8;
    float* wfs = (float*)(lds + 98304);
    for (int k = tid; k < DM; k += 512) { const f32x4 w = *(const f32x4*)(P.w_in_even + (size_t)k * EVEN_IN + 3072); const float g = P.norm_g[k]; *(f32x4*)(wfs + 4 * k) = w * g; }
    __syncthreads();
    bfr* xb = (bfr*)(ws + WS_A); float* rstd0 = (float*)(ws + WS_RSTD0); float* lf = (float*)(ws + WS_LF);
    const float bf0 = P.b_forget[0], bf1 = P.b_forget[1], bf2 = P.b_forget[2], bf3 = P.b_forget[3];
    for (int m0 = gw; m0 < TOK; m0 += 2 * NGW) {
        f32x4 vv[2][4];
#pragma unroll
        for (int q = 0; q < 2; ++q) { const int m = m0 + q * NGW; if (m < TOK) { const f32x4* xr = (const f32x4*)(P.x + (size_t)m * DM) + lane;
#pragma unroll
            for (int j = 0; j < 4; ++j) vv[q][j] = __builtin_nontemporal_load(xr + 64 * j); } }
#pragma unroll
        for (int q = 0; q < 2; ++q) { const int m = m0 + q * NGW; if (m >= TOK) break;
        f32x4 v[4]; float ss = 0.f; f32x4 fa = {0.f, 0.f, 0.f, 0.f};
#pragma unroll
        for (int j = 0; j < 4; ++j) { v[j] = vv[q][j]; ss += (v[j][0] * v[j][0] + v[j][1] * v[j][1]) + (v[j][2] * v[j][2] + v[j][3] * v[j][3]);
#pragma unroll
            for (int i = 0; i < 4; ++i) { const f32x4 w = *(const f32x4*)(wfs + 4 * (256 * j + 4 * lane + i)); fa += w * v[j][i]; } }
        ss = wave_sum(ss, lane); const float rs = __builtin_amdgcn_rsqf(ss * (1.f / DM) + RMS_EPS);
        fa[0] = wave_sum(fa[0], lane); fa[1] = wave_sum(fa[1], lane); fa[2] = wave_sum(fa[2], lane); fa[3] = wave_sum(fa[3], lane);
        unsigned long long* o8 = (unsigned long long*)(xb + (size_t)m * DM) + lane;
#pragma unroll
        for (int j = 0; j < 4; ++j) o8[64 * j] = (unsigned long long)cvtpk(v[j][0], v[j][1]) | ((unsigned long long)cvtpk(v[j][2], v[j][3]) << 32);
        if (lane < 4) { const float y = (lane == 0 ? fa[0] : lane == 1 ? fa[1] : lane == 2 ? fa[2] : fa[3]) * rs + (lane == 0 ? bf0 : lane == 1 ? bf1 : lane == 2 ? bf2 : bf3);
            const float ls = fminf(y, 0.f) - log1pf(__expf(-fabsf(y)));
            const int b = m / SEQ, s = m % SEQ; lf[(size_t)(b * 4 + lane) * SEQ + s] = ls; }
        if (lane == 0) rstd0[m] = rs; }
    }
    { float* rope = (float*)(ws + WS_ROPE);
      for (int e = blk * 512 + tid; e < TOK * 16; e += G * 512) { const int t = e >> 4, i = e & 15;
          const float invf = expf(-13.122363377404328f * (float)i / 16.f), ang = (float)P.positions[t] * invf;
          const double rev = (double)ang * 0.15915494309189535; const float fr = (float)(rev - rint(rev));
          rope[t * 32 + i] = __builtin_amdgcn_cosf(fr); rope[t * 32 + 16 + i] = __builtin_amdgcn_sinf(fr); } }
    __syncthreads();
    float* scr = (float*)(lds + wave * 16384);
    constexpr int I0 = 16 * 96, I1 = 16 * 32, I2 = 512, I3 = 16 * 128, I4 = 512, I5 = 512, I6 = 512, I7 = 128, I8 = 128;
    for (int it = gw; it < I0 + I1; it += NGW) { int r = it;
        if (r < I0) { transpose_item(P.w_in_even, EVEN_IN, 0, DM, 3072, P.norm_g, (bfr*)(ws + WS_W0T), 0, scr, r, lane); continue; } r -= I0;
        transpose_item(P.w_in_even, EVEN_IN, 3076, DM, 1024, P.norm_g, (bfr*)(ws + WS_W0T), 3072, scr, r, lane);
    }
}
__device__ __forceinline__ void phase_late_weights(const Params& P, char* lds, int G, int blk) {
    unsigned char* ws = P.ws;
    int tid_l = threadIdx.x; asm volatile("" : "+v"(tid_l));
    const int tid = tid_l, lane = tid & 63, wave = tid >> 6;
    const int gw = blk * 8 + wave, NGW = G * 8;
    float* scr = (float*)(lds + wave * 16384);
    constexpr int I2 = 512, I3 = 16 * 128, I4 = 512, I5 = 512, I6 = 512, I7 = 128, I8 = 128;
    constexpr int NIT = I2 + I3 + I4 + I5 + I6 + I7 + I8;
    for (int it = gw; it < NIT; it += NGW) { int r = it;
        if (r < I2) { transpose_item(P.w_out_even, DM, 0, DM, DM, nullptr, (bfr*)(ws + WS_WO0T), 0, scr, r, lane); continue; } r -= I2;
        if (r < I3) { transpose_item(P.w_in_odd, NPROJ, 0, DM, NPROJ, P.norm_g + DM, (bfr*)(ws + WS_W1T), 0, scr, r, lane); continue; } r -= I3;
        if (r < I4) { transpose_item(P.w_out_odd, DM, 0, DM, DM, nullptr, (bfr*)(ws + WS_WO1T), 0, scr, r, lane); continue; } r -= I4;
        if (r < I5) { transpose_item(P.w_ple_gate, DM, 0, DM, DM, nullptr, (bfr*)(ws + WS_WG0T), 0, scr, r, lane); continue; } r -= I5;
        if (r < I6) { transpose_item(P.w_ple_gate + (size_t)DM * DM, DM, 0, DM, DM, nullptr, (bfr*)(ws + WS_WG1T), 0, scr, r, lane); continue; } r -= I6;
        if (r < I7) { transpose_item(P.w_ple, DM, 0, PLE, DM, nullptr, (bfr*)(ws + WS_WP0T), 0, scr, r, lane); continue; } r -= I7;
        transpose_item(P.w_ple + (size_t)PLE * DM, DM, 0, PLE, DM, nullptr, (bfr*)(ws + WS_WP1T), 0, scr, r, lane);
    }
    __syncthreads();
}
__device__ __forceinline__ void convert_p(const float* p, bfr* pb, int G, int blk) {
    const size_t n8 = (size_t)TOK * PLE / 8;
    int tid_l = threadIdx.x; asm volatile("" : "+v"(tid_l));
    const size_t stride = (size_t)G * 512;
    for (size_t i0 = (size_t)blk * 512 + tid_l; i0 < n8; i0 += 4 * stride) {
        f32x4 av[4], bv[4];
#pragma unroll
        for (int q = 0; q < 4; ++q) { const size_t i = i0 + q * stride; if (i < n8) { av[q] = __builtin_nontemporal_load((const f32x4*)(p + 8 * i)); bv[q] = __builtin_nontemporal_load((const f32x4*)(p + 8 * i + 4)); } }
#pragma unroll
        for (int q = 0; q < 4; ++q) { const size_t i = i0 + q * stride; if (i >= n8) break; const f32x4 a = av[q], b = bv[q];
        u32x4 w; w.x = cvtpk(a[0], a[1]); w.y = cvtpk(a[2], a[3]); w.z = cvtpk(b[0], b[1]); w.w = cvtpk(b[2], b[3]);
        *(u32x4*)(pb + 8 * i) = w; } }
}
__device__ __forceinline__ void cumsum_seq(const float* lf, float* c, char* lds) {
    int tid_l = threadIdx.x; asm volatile("" : "+v"(tid_l));
    const int tid = tid_l, lane = tid & 63, wave = tid >> 6;
    float* sh = (float*)lds;
    const f32x4 a = *(const f32x4*)(lf + tid * 8), b = *(const f32x4*)(lf + tid * 8 + 4);
    float v[8] = {a[0], a[1], a[2], a[3], b[0], b[1], b[2], b[3]};
#pragma unroll
    for (int i = 1; i < 8; ++i) v[i] += v[i - 1];
    float x = v[7];
#pragma unroll
    for (int o = 1; o < 64; o <<= 1) { const float t = __int_as_float(__builtin_amdgcn_ds_bpermute((lane - o) << 2, __float_as_int(x))); if (lane >= o) x += t; }
    if (lane == 63) sh[wave] = x;
    __syncthreads();
    float woff = 0.f;
    for (int w = 0; w < wave; ++w) woff += sh[w];
    const float ex = x - v[7] + woff;
    constexpr float L2E = 1.4426950408889634f;
    f32x4 oa = {(v[0] + ex) * L2E, (v[1] + ex) * L2E, (v[2] + ex) * L2E, (v[3] + ex) * L2E}, ob = {(v[4] + ex) * L2E, (v[5] + ex) * L2E, (v[6] + ex) * L2E, (v[7] + ex) * L2E};
    *(f32x4*)(c + tid * 8) = oa; *(f32x4*)(c + tid * 8 + 4) = ob;
    __syncthreads();
}
template <int LAYER>
__device__ __forceinline__ void nr_pass(const Params& P, bfr* proj, int G, int blk) {
    int tid_l = threadIdx.x; asm volatile("" : "+v"(tid_l));
    const int tid = tid_l, j = tid & 15, sg = (tid >> 4) & 15, rsel = tid >> 8, ln = tid & 63;
    int col, gw; const float* gain; float scale; bool rope;
    if (LAYER == 0) {
        if (sg < 4) { col = sg * 128; gw = 64; gain = P.qn_a; scale = 0.125f; rope = true; }
        else if (sg < 8) { col = 512 + (sg - 4) * 128; gw = 64; gain = P.kn_a; scale = 1.f; rope = true; }
        else if (sg < 12) { col = 1536 + (sg - 8) * 128; gw = 128; gain = P.qn_b; scale = 0.08838834764831845f; rope = false; }
        else { col = 2048 + (sg - 12) * 128; gw = 128; gain = P.kn_b; scale = 1.f; rope = false; }
    } else {
        if (sg < 8) { col = sg * 128; gw = 128; gain = P.qn_c; scale = 0.08838834764831845f; rope = true; }
        else { col = 1024 + (sg - 8) * 128; gw = 128; gain = P.kn_c; scale = 1.f; rope = true; }
    }
    const int jj = (gw == 128) ? j : (j & 7);
    float gn[8];
#pragma unroll
    for (int e = 0; e < 8; ++e) gn[e] = gain[jj * 8 + e];
    const int half = gw / 8, pd = (gw == 128) ? 2 : 1;
    const bool rl = rope && (jj < ((gw == 128) ? 4 : 2));
    const bool isx2 = (gw == 128) ? ((jj & 2) != 0) : ((jj & 1) != 0);
    const int ibase = (gw == 128) ? (jj & 1) * 8 : 0;
    float invf[8];
#pragma unroll
    for (int e = 0; e < 8; ++e) invf[e] = expf(-13.122363377404328f * (float)(ibase + e) / (float)half);
    for (int rp0 = blk; rp0 < TOK / 2; rp0 += 4 * G) {
        u32x4 rawv[4]; float posv[4];
#pragma unroll
        for (int q = 0; q < 4; ++q) { const int rp = rp0 + q * G; if (rp < TOK / 2) { const int row = rp * 2 + rsel;
            rawv[q] = *(const u32x4*)(proj + (size_t)row * NPROJ + col + j * 8); posv[q] = rl ? (float)P.positions[row] : 0.f; } }
#pragma unroll
        for (int q = 0; q < 4; ++q) { const int rp = rp0 + q * G; if (rp >= TOK / 2) break;
        const int row = rp * 2 + rsel;
        bfr* ptr = proj + (size_t)row * NPROJ + col + j * 8;
        const u32x4 raw = rawv[q];
        float f[8] = {__uint_as_float(raw.x << 16), __uint_as_float(raw.x & 0xffff0000u), __uint_as_float(raw.y << 16), __uint_as_float(raw.y & 0xffff0000u),
                      __uint_as_float(raw.z << 16), __uint_as_float(raw.z & 0xffff0000u), __uint_as_float(raw.w << 16), __uint_as_float(raw.w & 0xffff0000u)};
        float ss = 0.f;
#pragma unroll
        for (int e = 0; e < 8; ++e) ss += f[e] * f[e];
        ss += shx(ss, 1, ln); ss += shx(ss, 2, ln); ss += shx(ss, 4, ln);
        { const float t = shx(ss, 8, ln); if (gw == 128) ss += t; }
        const float rs = __builtin_amdgcn_rsqf(ss / (float)gw + RMS_EPS);
        float v[8], pr[8];
#pragma unroll
        for (int e = 0; e < 8; ++e) v[e] = f[e] * rs * gn[e];
#pragma unroll
        for (int e = 0; e < 8; ++e) pr[e] = shx(v[e], pd, ln);
        if (rl) { const float pos = posv[q];
#pragma unroll
            for (int e = 0; e < 8; ++e) { const float ang = pos * invf[e]; const double rev = (double)ang * 0.15915494309189535; const float fr = (float)(rev - rint(rev));
                const float sn = __builtin_amdgcn_sinf(fr), cs = __builtin_amdgcn_cosf(fr);
                v[e] = isx2 ? (v[e] * cs + pr[e] * sn) : (v[e] * cs - pr[e] * sn); } }
        u32x4 w; w.x = cvtpk(v[0] * scale, v[1] * scale); w.y = cvtpk(v[2] * scale, v[3] * scale); w.z = cvtpk(v[4] * scale, v[5] * scale); w.w = cvtpk(v[6] * scale, v[7] * scale);
        *(u32x4*)ptr = w; }
    }
}

__device__ __forceinline__ void store_pair_bf16(bfr* p, float v, int r32) { const float vn = __shfl_xor(v, 1); if ((r32 & 1) == 0) *(unsigned*)p = cvtpk(v, vn); }

__device__ __forceinline__ float bflo(unsigned w) { return __uint_as_float(w << 16); }
__device__ __forceinline__ float bfhi(unsigned w) { return __uint_as_float(w & 0xffff0000u); }
__device__ __forceinline__ void phase_attn0(const Params& P, char* lds, int G, int blk) {
    unsigned char* ws = P.ws;
    const bfr* proj = (const bfr*)(ws + WS_PROJ); bfr* mixed = (bfr*)(ws + WS_CC); float* o1s = (float*)(ws + WS_B); const float* cc = (const float*)(ws + WS_C);
    int tid_l = threadIdx.x; asm volatile("" : "+v"(tid_l));
    const int tid = tid_l, wid = __builtin_amdgcn_readfirstlane(tid >> 6), lane = tid & 63, r32 = lane & 31, hi = lane >> 5;
    float lam;
    { const float a = wave_sum(P.lam_q1[lane] * P.lam_k1[lane], lane), b = wave_sum(P.lam_q2[lane] * P.lam_k2[lane], lane); lam = expf(a) - expf(b) + LAM_INIT0; }
    const int vblk = (G % 8 == 0) ? (blk % 8) * (G / 8) + blk / 8 : blk;
    att::bf16x8 qr[8]; bool have_q = false;
    for (int w = vblk; w < 256; w += G) {
        const int bh = w >> 3, s = w & 7, b = bh >> 2, h = bh & 3;
        const size_t tok0 = (size_t)b * SEQ;
        for (int pass = 0; pass < 2; ++pass) {
            const int qb = pass == 0 ? 15 - s : s;
            att::f32x16 o[4]; float m_reg, l_reg;
            att::Unit U; U.stride = NPROJ; U.q0 = qb * 256; U.j_lo = 0; U.j_hi = (qb + 1) * 4; U.W = 1 << 29;
            U.Q = proj + tok0 * NPROJ + 1536 + h * 128; U.K = proj + tok0 * NPROJ + 2048 + h * 128; U.V = proj + tok0 * NPROJ + 2560 + h * 128; U.c = cc + (size_t)bh * SEQ;
            att::unit_core<128, true, false>(U, lds, o, m_reg, l_reg, qr, have_q, proj + tok0 * NPROJ + h * 128, NPROJ, U.q0, 4); have_q = true;
            { int ln_ = lane; asm volatile("" : "+v"(ln_)); const int row = ln_ >> 1, half = ln_ & 1;
              const float* stg = (const float*)(lds + wid * 16384);
              const size_t tk = tok0 + U.q0 + wid * 32 + row; const int c0 = 512 + h * 128 + half * 64;
              const u32x4* zp = (const u32x4*)(proj + tk * NPROJ + 3072 + c0); u32x4* mp = (u32x4*)(mixed + tk * DM + c0);
              u32x4 zq[8];
#pragma unroll
              for (int j = 0; j < 8; ++j) zq[j] = zp[(j + row) & 7];
#pragma unroll
              for (int j = 0; j < 8; ++j) { const int jp = (j + row) & 7; const f32x4 a = att::stg_chunk(stg, row, half, 2 * jp), c = att::stg_chunk(stg, row, half, 2 * jp + 1); const u32x4 z = zq[j]; u32x4 wv;
                  wv.x = cvtpk(a[0] * silu_f(bflo(z.x)), a[1] * silu_f(bfhi(z.x))); wv.y = cvtpk(a[2] * silu_f(bflo(z.y)), a[3] * silu_f(bfhi(z.y)));
                  wv.z = cvtpk(c[0] * silu_f(bflo(z.z)), c[1] * silu_f(bfhi(z.z))); wv.w = cvtpk(c[2] * silu_f(bflo(z.w)), c[3] * silu_f(bfhi(z.w)));
                  mp[jp] = wv; } }
            __syncthreads();
            U.V = proj + tok0 * NPROJ + 1024 + h * 128; U.c = nullptr;
            U.Q = proj + tok0 * NPROJ + h * 128; U.K = proj + tok0 * NPROJ + 512 + h * 128;
            att::unit_core<64, false, false>(U, lds, o, m_reg, l_reg, qr, true, U.Q + 64, NPROJ, U.q0, 4);
            { int ln_ = lane; asm volatile("" : "+v"(ln_)); const int row = ln_ >> 1, half = ln_ & 1;
              const float* stg = (const float*)(lds + wid * 16384);
              const size_t tk = tok0 + U.q0 + wid * 32 + row;
              f32x4* op = (f32x4*)(o1s + tk * 512 + h * 128 + half * 64);
#pragma unroll
              for (int j = 0; j < 16; ++j) { const int jp = (j + 2 * row) & 15; op[jp] = att::stg_chunk(stg, row, half, jp); } }
            __syncthreads();
            U.Q += 64; U.K += 64;
            {
              const bfr* nq = nullptr; int nq0 = 0, nfr = 0;
              if (pass == 0) { nq = proj + tok0 * NPROJ + 1536 + h * 128; nq0 = s * 256; nfr = 8; }
              else if (w + G < 256) { const int w2 = w + G, bh2 = w2 >> 3, s2 = w2 & 7; nq = proj + (size_t)(bh2 >> 2) * SEQ * NPROJ + 1536 + (bh2 & 3) * 128; nq0 = (15 - s2) * 256; nfr = 8; }
              att::unit_core<64, false, false>(U, lds, o, m_reg, l_reg, qr, true, nq, NPROJ, nq0, nfr); }
            { int ln_ = lane; asm volatile("" : "+v"(ln_)); const int row = ln_ >> 1, half = ln_ & 1;
              const float* stg = (const float*)(lds + wid * 16384);
              const size_t tk = tok0 + U.q0 + wid * 32 + row; const int c0 = h * 128 + half * 64;
              const f32x4* op = (const f32x4*)(o1s + tk * 512 + c0);
              const u32x4* zp = (const u32x4*)(proj + tk * NPROJ + 3072 + c0); u32x4* mp = (u32x4*)(mixed + tk * DM + c0);
              const f32x4* gp = (const f32x4*)(P.subln_g + half * 64);
              f32x4 v[16]; u32x4 zq[8]; float ss = 0.f;
#pragma unroll
              for (int j = 0; j < 16; ++j) v[j] = op[(j + 2 * row) & 15];
#pragma unroll
              for (int j = 0; j < 8; ++j) zq[j] = zp[(j + row) & 7];
#pragma unroll
              for (int j = 0; j < 16; ++j) { v[j] = v[j] - att::stg_chunk(stg, row, half, (j + 2 * row) & 15) * lam; ss += (v[j][0] * v[j][0] + v[j][1] * v[j][1]) + (v[j][2] * v[j][2] + v[j][3] * v[j][3]); }
              ss += __int_as_float(__builtin_amdgcn_ds_bpermute((ln_ ^ 1) << 2, __float_as_int(ss)));
              const float rs = __builtin_amdgcn_rsqf(ss * (1.f / 128.f) + RMS_EPS) * (1.f - LAM_INIT0);
#pragma unroll
              for (int j = 0; j < 8; ++j) { const int jp = (j + row) & 7; const f32x4 ga = gp[2 * jp], gb = gp[2 * jp + 1]; const f32x4 a = v[2 * j] * ga * rs, c = v[2 * j + 1] * gb * rs; const u32x4 z = zq[j]; u32x4 wv;
                  wv.x = cvtpk(a[0] * silu_f(bflo(z.x)), a[1] * silu_f(bfhi(z.x))); wv.y = cvtpk(a[2] * silu_f(bflo(z.y)), a[3] * silu_f(bfhi(z.y)));
                  wv.z = cvtpk(c[0] * silu_f(bflo(z.z)), c[1] * silu_f(bfhi(z.z))); wv.w = cvtpk(c[2] * silu_f(bflo(z.w)), c[3] * silu_f(bfhi(z.w)));
                  mp[jp] = wv; } }
            __syncthreads();
        }
    }
}
__device__ __forceinline__ void phase_attn1(const Params& P, char* lds, int G, int blk) {
    unsigned char* ws = P.ws;
    const bfr* proj = (const bfr*)(ws + WS_PROJ); float* lse = (float*)(ws + WS_LSE);
    int tid_l = threadIdx.x; asm volatile("" : "+v"(tid_l));
    const int tid = tid_l, wid = __builtin_amdgcn_readfirstlane(tid >> 6), lane = tid & 63, r32 = lane & 31, hi = lane >> 5;
    const int vblk = (G % 8 == 0) ? (blk % 8) * (G / 8) + blk / 8 : blk;
    att::bf16x8 qr[8]; bool have_q = false;
    for (int u = vblk; u < 3072; u += G) {
        const int bh = u / 48, rem = u % 48, pat = rem >> 4, idx = rem & 15, b = bh >> 3, h = bh & 7;
        const int dil = pat == 0 ? 1 : pat == 1 ? 4 : 16;
        const int res = idx % dil, qb = idx / dil;
        const size_t tok0 = (size_t)b * SEQ + res;
        const bfr* nq = nullptr; long nstr = 0; int nq0 = 0, nfr = 0;
        if (u + G < 3072) { const int u2 = u + G, bh2 = u2 / 48, rem2 = u2 % 48, pat2 = rem2 >> 4, idx2 = rem2 & 15; const int dil2 = pat2 == 0 ? 1 : pat2 == 1 ? 4 : 16;
            nq = proj + ((size_t)(bh2 >> 3) * SEQ + (idx2 % dil2)) * NPROJ + (bh2 & 7) * 128; nstr = (long)NPROJ * dil2; nq0 = (idx2 / dil2) * 256; nfr = 8; }
        bfr* part = pat == 2 ? (bfr*)P.out : (bfr*)(ws + WS_A + (size_t)pat * 64 * MiB);
        att::f32x16 o[4]; float m_reg, l_reg;
        att::Unit U; U.stride = (long)NPROJ * dil; U.q0 = qb * 256; U.j_lo = qb == 0 ? 0 : (qb * 256 - 128) / 64; U.j_hi = (qb + 1) * 4; U.W = 129; U.c = nullptr;
        U.Q = proj + tok0 * NPROJ + h * 128; U.K = proj + tok0 * NPROJ + 1024 + h * 128; U.V = proj + tok0 * NPROJ + 2048 + h * 128;
        att::unit_core<128, false, true>(U, lds, o, m_reg, l_reg, qr, have_q, nq, nstr, nq0, nfr); have_q = true;
        if (hi == 0) { const size_t tk = tok0 + (size_t)(U.q0 + wid * 32 + r32) * dil; lse[((size_t)pat * TOK + tk) * 8 + h] = m_reg * 0.6931471805599453f + __logf(l_reg); }
        { int ln_ = lane; asm volatile("" : "+v"(ln_)); const int row = ln_ >> 1, half = ln_ & 1;
          const float* stg = (const float*)(lds + wid * 16384);
          const size_t tk = tok0 + (size_t)(U.q0 + wid * 32 + row) * dil;
          u32x4* pp = (u32x4*)(part + tk * DM + h * 128 + half * 64);
#pragma unroll
          for (int j = 0; j < 8; ++j) { const int jp = (j + row) & 7; const f32x4 a = att::stg_chunk(stg, row, half, 2 * jp), c = att::stg_chunk(stg, row, half, 2 * jp + 1); u32x4 wv;
              wv.x = cvtpk(a[0], a[1]); wv.y = cvtpk(a[2], a[3]); wv.z = cvtpk(c[0], c[1]); wv.w = cvtpk(c[2], c[3]); pp[jp] = wv; } }
        __syncthreads();
    }
}
__device__ __forceinline__ void phase_merge1(const Params& P, int G, int blk) {
    unsigned char* ws = P.ws;
    const bfr* proj = (const bfr*)(ws + WS_PROJ); const float* lse = (const float*)(ws + WS_LSE);
    bfr* p0 = (bfr*)(ws + WS_A); const bfr* p1 = (const bfr*)(ws + WS_B); const bfr* p2 = (const bfr*)P.out;
    const size_t n8 = (size_t)TOK * DM / 8;
    int tid_l = threadIdx.x; asm volatile("" : "+v"(tid_l));
    const size_t stride = (size_t)G * 512;
    for (size_t i0 = (size_t)blk * 512 + tid_l; i0 < n8; i0 += 4 * stride) {
        u32x4 av[4], bv[4], cv[4], zv[4]; float lv[4][3];
#pragma unroll
        for (int q = 0; q < 4; ++q) { const size_t i = i0 + q * stride; if (i < n8) { const size_t tk = i >> 7; const int c = (int)(i & 127) * 8, h = c >> 7;
            lv[q][0] = lse[((size_t)0 * TOK + tk) * 8 + h]; lv[q][1] = lse[((size_t)1 * TOK + tk) * 8 + h]; lv[q][2] = lse[((size_t)2 * TOK + tk) * 8 + h];
            av[q] = __builtin_nontemporal_load((const u32x4*)(p0 + tk * DM + c)); bv[q] = __builtin_nontemporal_load((const u32x4*)(p1 + tk * DM + c)); cv[q] = __builtin_nontemporal_load((const u32x4*)(p2 + tk * DM + c)); zv[q] = __builtin_nontemporal_load((const u32x4*)(proj + tk * NPROJ + 3072 + c)); } }
#pragma unroll
        for (int q = 0; q < 4; ++q) { const size_t i = i0 + q * stride; if (i >= n8) break; const size_t tk = i >> 7; const int c = (int)(i & 127) * 8;
        const float l0 = lv[q][0], l1 = lv[q][1], l2 = lv[q][2];
        const float mx = fmaxf(l0, fmaxf(l1, l2)); float w0 = __expf(l0 - mx), w1 = __expf(l1 - mx), w2 = __expf(l2 - mx); const float inv = 1.f / (w0 + w1 + w2); w0 *= inv; w1 *= inv; w2 *= inv;
        const u32x4 a = av[q], bq = bv[q], cq = cv[q], zq = zv[q];
        u32x4 ow;
#pragma unroll
        for (int k = 0; k < 4; ++k) {
            const float alo = __uint_as_float(a[k] << 16), ahi = __uint_as_float(a[k] & 0xffff0000u), blo = __uint_as_float(bq[k] << 16), bhi = __uint_as_float(bq[k] & 0xffff0000u);
            const float clo = __uint_as_float(cq[k] << 16), chi = __uint_as_float(cq[k] & 0xffff0000u), zlo = __uint_as_float(zq[k] << 16), zhi = __uint_as_float(zq[k] & 0xffff0000u);
            ow[k] = cvtpk((w0 * alo + w1 * blo + w2 * clo) * silu_f(zlo), (w0 * ahi + w1 * bhi + w2 * chi) * silu_f(zhi)); }
        *(u32x4*)(p0 + tk * DM + c) = ow; } }
}

#define LAS __attribute__((address_space(3)))
#define XB_TMO      128
#define XB_XCNT(j)  (256  + 64 * (j))
#define XB_XSUB(j)  (1280 + 64 * (j))
#define XB_XGEN(j)  (2304 + 64 * (j))
#define XB_TOP      3328
#define XB_TOPGEN   3392
#define XCD_BAR_WORDS 3456
#define XB_SPIN_CAP (1u << 18)

__device__ __forceinline__ unsigned xb_ld(unsigned* p)              { return __hip_atomic_load(p, __ATOMIC_RELAXED, __HIP_MEMORY_SCOPE_AGENT); }
__device__ __forceinline__ unsigned xb_add(unsigned* p, unsigned v) { return __hip_atomic_fetch_add(p, v, __ATOMIC_RELAXED, __HIP_MEMORY_SCOPE_AGENT); }
__device__ __forceinline__ unsigned xb_xcc_id() { return (unsigned)__builtin_amdgcn_s_getreg((3 << 11) | 20) & 0xFu; }
#define XB_SPIN(cond, bar) do { unsigned _sp = 0; while (cond) { __builtin_amdgcn_s_sleep(1); \
    if ((++_sp & 255u) == 0u) { if (xb_ld(&(bar)[XB_TMO])) break; if (_sp > XB_SPIN_CAP) { atomicAdd(&(bar)[XB_TMO], 1u); break; } } } } while (0)

struct XcdBarrier {
    unsigned* bar; unsigned x;
    volatile LAS unsigned* st;
};

__device__ __forceinline__ XcdBarrier xcd_barrier_post(unsigned* bar, volatile LAS unsigned* st) {
    XcdBarrier b; b.bar = bar; b.x = xb_xcc_id(); b.st = st;
    if (threadIdx.x == 0) (void)xb_add(&bar[XB_XCNT(b.x)], 1u);
    return b;
}
__device__ __forceinline__ void xcd_barrier_complete(unsigned* bar, unsigned x, unsigned& nloc, unsigned& nx) {
    const unsigned G = gridDim.x * gridDim.y * gridDim.z;
    unsigned sum, cnt, mine, sp = 0u;
    for (;;) {
        sum = 0u; cnt = 0u; mine = 0u;
#pragma unroll
        for (unsigned j = 0; j < 16; ++j) { const unsigned c = xb_ld(&bar[XB_XCNT(j)]); sum += c; cnt += (c > 0u) ? 1u : 0u; mine = (j == x) ? c : mine; }
        if (sum == G) break;
        __builtin_amdgcn_s_sleep(1);
        if ((++sp & 255u) == 0u) { if (xb_ld(&bar[XB_TMO])) break; if (sp > XB_SPIN_CAP) { atomicAdd(&bar[XB_TMO], 1u); break; } }
    }
    nloc = mine > 0u ? mine : 1u; nx = cnt > 0u ? cnt : 1u;
}

__device__ __forceinline__ void xcd_barrier(const XcdBarrier& b) {
    asm volatile("s_waitcnt vmcnt(0)" ::: "memory");
    __syncthreads();
    if (threadIdx.x == 0) {
        unsigned* bar = b.bar;
        __builtin_amdgcn_s_waitcnt(0);
        unsigned nloc = b.st[0], nx = b.st[1];
        if (nloc == 0u) { xcd_barrier_complete(bar, b.x, nloc, nx); b.st[0] = nloc; b.st[1] = nx; }
        const unsigned old = xb_add(&bar[XB_XSUB(b.x)], 1u);
        const unsigned gen = old / nloc;
        if (old + 1u == (gen + 1u) * nloc) {
            __builtin_amdgcn_fence(__ATOMIC_RELEASE, "agent");
            asm volatile("s_waitcnt vmcnt(0)" ::: "memory");
            const unsigned og = xb_add(&bar[XB_TOP], 1u);
            const unsigned tg = og / nx;
            if (og + 1u == (tg + 1u) * nx) xb_add(&bar[XB_TOPGEN], 1u);
            else XB_SPIN(xb_ld(&bar[XB_TOPGEN]) == tg, bar);
            __builtin_amdgcn_fence(__ATOMIC_ACQUIRE, "agent");
            xb_add(&bar[XB_XGEN(b.x)], 1u);
            asm volatile("s_waitcnt vmcnt(0)" ::: "memory");
        } else {
            XB_SPIN(xb_ld(&bar[XB_XGEN(b.x)]) == gen, bar);
            __builtin_amdgcn_fence(__ATOMIC_ACQUIRE, "agent");
            asm volatile("s_waitcnt vmcnt(0)" ::: "memory");
        }
    }
    __syncthreads();
}

#ifndef PH
#define PH 4095
#endif
#ifndef DUP
#define DUP 0
#endif
__global__ void __launch_bounds__(512, 2) fwd_mega(Params P) {
    extern __shared__ __attribute__((aligned(16))) unsigned char lds_raw[];
    cg::grid_group grid = cg::this_grid();
    char* lds = (char*)lds_raw; PG8_LAS unsigned char* lds3 = (PG8_LAS unsigned char*)lds_raw;
    unsigned char* ws = P.ws; const int G = gridDim.x, blk = blockIdx.x;
    bfr* proj = (bfr*)(ws + WS_PROJ); bfr* bufA = (bfr*)(ws + WS_A); bfr* bufB = (bfr*)(ws + WS_B); bfr* bufC = (bfr*)(ws + WS_CC); bfr* pb = (bfr*)(ws + WS_PB);
    float* ssq = (float*)(ws + WS_SSQ);
    volatile LAS unsigned* bst = (volatile LAS unsigned*)(lds3 + 134144);
    if (threadIdx.x < 2) bst[threadIdx.x] = 0u;
    __syncthreads();
    XcdBarrier xbar = xcd_barrier_post((unsigned*)(ws + WS_BAR), bst);
    if (G == 0x7fffffff) grid.sync();
#if PH & 1
    phase_prologue(P, lds, G, blk);
#endif
#if DUP & 1
    grid.sync(); phase_prologue(P, lds, G, blk); convert_p(P.p, pb, G, blk);
#endif
#if DUP & 4096
    for (int i = 0; i < 10; ++i) xcd_barrier(xbar);
#endif
    xcd_barrier(xbar);
#if PH & 2
    { pg8::Gemm g{bufA, (const bfr*)(ws + WS_W0T), TOK, NPROJ, DM}; pg8::StaticOrder S; S.init(TOK, NPROJ, G, blk);
      for (int w = blk; w < 32; w += G) cumsum_seq((const float*)(ws + WS_LF) + (size_t)w * SEQ, (float*)(ws + WS_C) + (size_t)w * SEQ, lds);
      EpiProjNR<0> E{proj, (const float*)(ws + WS_RSTD0), nullptr, (const float*)(ws + WS_ROPE), P.qn_a, P.kn_a, P.qn_b, P.kn_b, (float*)(lds + LDS_XCH)};
      pg8::gemm_phase<EpiProjNR<0>, pg8::StaticOrder, true, true>(lds3, g, S, E);
    }
#endif
    xcd_barrier(xbar);
#if PH & 8
    phase_late_weights(P, lds, G, blk); convert_p(P.p, pb, G, blk);
    phase_attn0(P, lds, G, blk);
#endif
#if DUP & 8
    xcd_barrier(xbar); phase_attn0(P, lds, G, blk);
#endif
    xcd_barrier(xbar);
#if PH & 16
    { pg8::Gemm g{bufC, (const bfr*)(ws + WS_WO0T), TOK, DM, DM}; pg8::StaticOrder S; S.init(TOK, DM, G, blk);
      EpiRes<false> E{P.x, nullptr, bufA};
      pg8::gemm_phase<EpiRes<false>, pg8::StaticOrder, true, true>(lds3, g, S, E);
    }
#endif
    xcd_barrier(xbar);
#if PH & 32
    { pg8::Gemm g{pb, (const bfr*)(ws + WS_WP0T), TOK, DM, PLE}; pg8::StaticOrder S; S.init(TOK, DM, G, blk);
      EpiT1 E{bufB};
      pg8::gemm_phase<EpiT1, pg8::StaticOrder, true, true>(lds3, g, S, E);
#if DUP & 32
      xcd_barrier(xbar); pg8::gemm_phase<EpiT1, pg8::StaticOrder, true, true>(lds3, g, S, E);
#endif
    }
    { pg8::Gemm g{bufA, (const bfr*)(ws + WS_WG0T), TOK, DM, DM}; pg8::StaticOrder S; S.init(TOK, DM, G, blk);
      EpiGate E{bufA, bufB, bufC, ssq, nullptr};
      pg8::gemm_phase<EpiGate, pg8::StaticOrder, true, true>(lds3, g, S, E); }
#endif
    xcd_barrier(xbar);
#if PH & 64
    { pg8::Gemm g{bufC, (const bfr*)(ws + WS_W1T), TOK, NPROJ, DM}; pg8::StaticOrder S; S.init(TOK, NPROJ, G, blk);
      EpiProjNR<1> E{proj, nullptr, ssq, (const float*)(ws + WS_ROPE), nullptr, nullptr, P.qn_c, P.kn_c, (float*)(lds + LDS_XCH)};
      pg8::gemm_phase<EpiProjNR<1>, pg8::StaticOrder, true, true>(lds3, g, S, E); }
#endif
    xcd_barrier(xbar);
#if PH & 256
    convert_p(P.p + (size_t)TOK * PLE, pb, G, blk);
    phase_attn1(P, lds, G, blk);
#endif
#if DUP & 256
    xcd_barrier(xbar); phase_attn1(P, lds, G, blk);
#endif
    xcd_barrier(xbar);
#if PH & 512
    phase_merge1(P, G, blk);
#endif
    xcd_barrier(xbar);
#if PH & 1024
    { pg8::Gemm g{bufA, (const bfr*)(ws + WS_WO1T), TOK, DM, DM}; pg8::StaticOrder S; S.init(TOK, DM, G, blk);
      EpiRes<true> E{nullptr, bufC, bufB};
      pg8::gemm_phase<EpiRes<true>, pg8::StaticOrder, true, true>(lds3, g, S, E); }
#endif
    xcd_barrier(xbar);
#if PH & 2048
    { pg8::Gemm g{pb, (const bfr*)(ws + WS_WP1T), TOK, DM, PLE}; pg8::StaticOrder S; S.init(TOK, DM, G, blk);
      EpiT1 E{bufA};
      pg8::gemm_phase<EpiT1, pg8::StaticOrder, true, true>(lds3, g, S, E); }
    { pg8::Gemm g{bufB, (const bfr*)(ws + WS_WG1T), TOK, DM, DM}; pg8::StaticOrder S; S.init(TOK, DM, G, blk);
      EpiGate E{bufB, bufA, nullptr, nullptr, P.out};
      pg8::gemm_phase<EpiGate, pg8::StaticOrder, true, true>(lds3, g, S, E); }
#endif
}

extern "C" void kernel_launch(void* const* d_in, const int* in_sizes, int n_in, void* d_out, int out_size, void* d_ws, size_t ws_size, hipStream_t stream) {
    static int grid = 0;
    if (!grid) {
        if (n_in != 22 || out_size != TOK * DM || ws_size < WS_END) { fprintf(stderr, "kernel_launch: unexpected shapes (n_in %d out %d ws %zu)\n", n_in, out_size, ws_size); grid = -1; return; }
        int dev = 0, cus = 0, per_cu = 0;
        (void)hipGetDevice(&dev); (void)hipDeviceGetAttribute(&cus, hipDeviceAttributeMultiprocessorCount, dev);
        (void)hipFuncSetAttribute((const void*)fwd_mega, hipFuncAttributeMaxDynamicSharedMemorySize, LDS_BYTES);
        (void)hipOccupancyMaxActiveBlocksPerMultiprocessor(&per_cu, (const void*)fwd_mega, 512, LDS_BYTES);
        if (per_cu < 1) per_cu = 1;
        grid = cus * per_cu;
        fprintf(stderr, "grid %d (cus %d per_cu %d) ws %zu\n", grid, cus, per_cu, ws_size);
    }
    if (grid < 0) return;
    Params p{};
    p.x = (const float*)d_in[0]; p.p = (const float*)d_in[1]; p.positions = (const int*)d_in[2]; p.norm_g = (const float*)d_in[3]; p.w_in_even = (const float*)d_in[4];
    p.b_forget = (const float*)d_in[5]; p.qn_a = (const float*)d_in[6]; p.kn_a = (const float*)d_in[7]; p.qn_b = (const float*)d_in[8]; p.kn_b = (const float*)d_in[9];
    p.lam_q1 = (const float*)d_in[10]; p.lam_k1 = (const float*)d_in[11]; p.lam_q2 = (const float*)d_in[12]; p.lam_k2 = (const float*)d_in[13]; p.subln_g = (const float*)d_in[14];
    p.w_out_even = (const float*)d_in[15]; p.w_in_odd = (const float*)d_in[16]; p.qn_c = (const float*)d_in[17]; p.kn_c = (const float*)d_in[18]; p.w_out_odd = (const float*)d_in[19];
    p.w_ple = (const float*)d_in[20]; p.w_ple_gate = (const float*)d_in[21]; p.out = (float*)d_out; p.ws = (unsigned char*)d_ws;
    (void)hipMemsetAsync((char*)d_ws + WS_BAR, 0, BAR_BYTES, stream);
    void* args[] = {&p};
    hipError_t e = hipLaunchCooperativeKernel((const void*)fwd_mega, dim3(grid), dim3(512), args, LDS_BYTES, stream);
    if (e != hipSuccess) fprintf(stderr, "cooperative launch failed: %s (grid %d)\n", hipGetErrorString(e), grid);
}
```

```cpp
#include <hip/hip_runtime.h>
#include <hip/hip_bf16.h>
#include <hip/hip_cooperative_groups.h>
#include <cstdio>
#include <cstdint>
#include <cmath>
namespace cg = cooperative_groups;
namespace pg8 {
#define PG8_LAS __attribute__((address_space(3)))
typedef unsigned short bf16_t;
typedef short bf16x8 __attribute__((ext_vector_type(8)));
typedef float f32x4 __attribute__((ext_vector_type(4)));
typedef unsigned u32x4 __attribute__((ext_vector_type(4)));
constexpr int BM = 256, BK = 64, HALF = 128, HTB = HALF * BK * 2  , STAGE_BYTES = 8 * HTB, NXCD = 8, WGM = 8;

__host__ __device__ __forceinline__ int lds_byte(int r, int c) { const int st = (r >> 4) * 2 + (c >> 5), rr = r & 15, cc = c & 31, ob = rr * 64 + cc * 2; return st * 1024 + (ob ^ (((ob >> 9) & 1) << 5)); }
__host__ __device__ __forceinline__ void stage_rc(int b, int& R, int& C) { const int st = b / 1024, sb = b % 1024, swz = sb ^ (((sb >> 9) & 1) << 5); R = (st >> 1) * 16 + swz / 64; C = (st & 1) * 32 + (swz % 64) / 2; }
__host__ __device__ __forceinline__ int perm32(int rho) { const int n = rho >> 4, i = rho & 15; return 8 * (i >> 2) + 4 * n + (i & 3); }

struct Unit { int pm, pn; };
struct Gemm { const bf16_t* A; const bf16_t* Bt; int M, N, K; };

struct StaticOrder {
    int nM, nN, nwg, G, c;
    __host__ __device__ void init(int M, int N, int G_, int c_) { nM = M / BM; nN = N / BM; nwg = nM * nN; G = G_; c = c_; }
    __host__ __device__ bool next(int i, Unit& u) const {
        const long L = (long)i * G + c; if (L >= nwg) return false;
        int wgid = (int)L; { const int q = nwg / NXCD, r = nwg % NXCD, xcd = wgid % NXCD, off = wgid / NXCD; wgid = (xcd < r ? xcd * (q + 1) : r * (q + 1) + (xcd - r) * q) + off; }
        const int nig = WGM * nN, gid = wgid / nig, fm = gid * WGM, gsz = (nM - fm) < WGM ? (nM - fm) : WGM;
        u.pm = fm + ((wgid % nig) % gsz); u.pn = (wgid % nig) / gsz; return true;
    }
    __device__ __forceinline__ void a_ready(const Unit&) const {}
    __device__ __forceinline__ void done(const Unit&) const {}
};

__device__ __forceinline__ unsigned cvt_pk_bf16(float lo, float hi) { unsigned r; asm volatile("v_cvt_pk_bf16_f32 %0, %1, %2" : "=v"(r) : "v"(lo), "v"(hi)); return r; }
typedef float f32x2 __attribute__((ext_vector_type(2)));
__device__ __forceinline__ f32x2 gelu_pk(f32x2 v) {
    const f32x2 av = __builtin_elementwise_abs(v), d = av * 0.2316418882f + 1.0f;
    f32x2 t; t.x = __builtin_amdgcn_rcpf(d.x); t.y = __builtin_amdgcn_rcpf(d.y);
    f32x2 q = t * 0.5307027145f + (-0.7265760135f); q = q * t + 0.7107068705f; q = q * t + (-0.142248368f); q = q * t + 0.127414796f; q = q * t;
    const f32x2 s = (v * v) * (-0.72134752044f);
    f32x2 e; e.x = __builtin_amdgcn_exp2f(s.x); e.y = __builtin_amdgcn_exp2f(s.y);
    const f32x2 m = v * (q * e), r = v - m;
    f32x2 o; o.x = v.x < 0.f ? m.x : r.x; o.y = v.y < 0.f ? m.y : r.y; return o;
}

template <int ACT  > struct EpiBf16 {
    static constexpr bool PERM = true, AFTER_DRAIN = false; static_assert(ACT == 0 || ACT == 1, "EpiBf16: ACT is 0 (none) or 1 (gelu_pk)");
    bf16_t* O; int ldc; const float* bias; int split_cols; size_t split_stride; float scale0;
    __device__ __forceinline__ void operator()(const f32x4 (&acc)[2][2][4][2], const Unit& u, int wr, int wc, int fr, int fq) const {
        const int row0 = u.pm * BM + wr * 64 + fr; int colt = u.pn * BM; bf16_t* base = O;
        float sc = 1.f; if (split_cols) { const int t = colt / split_cols; base += (size_t)t * split_stride; colt -= t * split_cols; if (t == 0) sc = scale0; }
        const int col0 = colt + wc * 32 + 8 * fq, bcol0 = u.pn * BM + wc * 32 + 8 * fq;
        f32x4 bv[2][2];
#pragma unroll
        for (int bj = 0; bj < 2; ++bj)
#pragma unroll
            for (int n = 0; n < 2; ++n) bv[bj][n] = bias ? *(const f32x4*)(bias + bcol0 + bj * HALF + 4 * n) : (f32x4){0.f, 0.f, 0.f, 0.f};
#pragma unroll
        for (int ai = 0; ai < 2; ++ai)
#pragma unroll
            for (int m = 0; m < 4; ++m) { bf16_t* rowp = base + (size_t)(row0 + ai * HALF + m * 16) * ldc + col0;
#pragma unroll
                for (int bj = 0; bj < 2; ++bj) { f32x4 v0 = acc[ai][bj][m][0] + bv[bj][0], v1 = acc[ai][bj][m][1] + bv[bj][1];
                    if (ACT == 1) { f32x2 a = gelu_pk((f32x2){v0[0], v0[1]}), b = gelu_pk((f32x2){v0[2], v0[3]}), c = gelu_pk((f32x2){v1[0], v1[1]}), d = gelu_pk((f32x2){v1[2], v1[3]});
                        v0 = (f32x4){a.x, a.y, b.x, b.y}; v1 = (f32x4){c.x, c.y, d.x, d.y}; }
                    v0 = v0 * sc; v1 = v1 * sc; u32x4 w; w.x = cvt_pk_bf16(v0[0], v0[1]); w.y = cvt_pk_bf16(v0[2], v0[3]); w.z = cvt_pk_bf16(v1[0], v1[1]); w.w = cvt_pk_bf16(v1[2], v1[3]);
                    *(u32x4*)(rowp + bj * HALF) = w; } }
    }
};
template <class Epi, class Sched, bool ALIGN_EPI = false, bool SP2 = false>
__device__ __forceinline__ void gemm_phase(PG8_LAS unsigned char* lds, const Gemm g, const Sched& S, const Epi& E) {
    int tid_l = threadIdx.x; asm volatile("" : "+v"(tid_l));
    const int tid = tid_l, wid = __builtin_amdgcn_readfirstlane(tid >> 6), lane = tid & 63, wr = wid >> 2, wc = wid & 3, fr = lane & 15, fq = lane >> 4;
    int K_l = g.K; asm volatile("" : "+s"(K_l));
    const int K = K_l, nt = K / BK;
    unsigned voffA[2], voffB[2];
#pragma unroll
    for (int i = 0; i < 2; ++i) { int R, C; stage_rc(tid * 16 + i * 8192, R, C); const int Rb = Epi::PERM ? ((R & ~31) + perm32(R & 31)) : R;
        voffA[i] = (unsigned)(R * K + C) * 2u; voffB[i] = (unsigned)(Rb * K + C) * 2u; }
    const size_t kstep = (size_t)(BK * 2);
    const size_t hstep = (size_t)HALF * K * 2;
    const size_t tstep = 2 * hstep;
    const unsigned ldsw = (unsigned)wid * 1024u;
    const int aoff = lds_byte(wr * 64 + fr, fq * 8), boff = lds_byte(wc * 32 + fr, fq * 8);
#define PG8_SA(b, h) (((b) * 2 + (h)) * HTB)
#define PG8_SB(b, h) ((4 + (b) * 2 + (h)) * HTB)
#define PG8_STAGE(bufoff, gbase, voff) do { _Pragma("unroll") for (int _i = 0; _i < 2; ++_i) \
        __builtin_amdgcn_global_load_lds((const unsigned*)((const char*)(gbase) + (voff)[_i]), (PG8_LAS unsigned*)(lds + (bufoff) + ldsw + _i * 8192), 16, 0, 0); } while (0)
#define PG8_LDA(dst, b, h) do { _Pragma("unroll") for (int m = 0; m < 4; ++m) _Pragma("unroll") for (int k = 0; k < 2; ++k) dst[m][k] = *(const PG8_LAS bf16x8*)(lds + PG8_SA(b, h) + aoff + m * 2048 + k * 1024); } while (0)
#define PG8_LDB(dst, b, h) do { _Pragma("unroll") for (int n = 0; n < 2; ++n) _Pragma("unroll") for (int k = 0; k < 2; ++k) dst[n][k] = *(const PG8_LAS bf16x8*)(lds + PG8_SB(b, h) + boff + n * 2048 + k * 1024); } while (0)
#define PG8_MMA(ai, bj, At, Bt) do { __builtin_amdgcn_s_setprio(1); _Pragma("unroll") for (int m = 0; m < 4; ++m) _Pragma("unroll") for (int n = 0; n < 2; ++n) _Pragma("unroll") for (int k = 0; k < 2; ++k) \
        acc[ai][bj][m][n] = __builtin_amdgcn_mfma_f32_16x16x32_bf16(Bt[n][k], At[m][k], acc[ai][bj][m][n], 0, 0, 0); __builtin_amdgcn_s_setprio(0); } while (0)
#define PG8_WAIT_V(n) asm volatile("s_waitcnt vmcnt(" #n ")" ::: "memory")
#define PG8_WAIT_L(n) asm volatile("s_waitcnt lgkmcnt(" #n ")" ::: "memory")
#define PG8_BAR __builtin_amdgcn_s_barrier()
#define PG8_SCHED __builtin_amdgcn_sched_barrier(0)
    Unit cur, nxt; int ui = 0;
    if (!S.next(0, cur)) return;
    f32x4 acc[2][2][4][2];
#pragma unroll
    for (int a = 0; a < 2; ++a)
#pragma unroll
        for (int b = 0; b < 2; ++b)
#pragma unroll
            for (int m = 0; m < 4; ++m)
#pragma unroll
                for (int n = 0; n < 2; ++n) acc[a][b][m][n] = (f32x4){0.f, 0.f, 0.f, 0.f};
    bf16x8 At[4][2], B0[2][2], B1[2][2];
    const char* cA = (const char*)g.A + (size_t)cur.pm * tstep; const char* cB = (const char*)g.Bt + (size_t)cur.pn * tstep;
    S.a_ready(cur);
    if constexpr (SP2) {
        PG8_STAGE(PG8_SB(0, 0), cB, voffB); PG8_STAGE(PG8_SB(0, 1), cB + hstep, voffB); PG8_STAGE(PG8_SA(0, 0), cA, voffA); PG8_STAGE(PG8_SA(0, 1), cA + hstep, voffA);
        if (wr == 1) PG8_BAR;
        PG8_WAIT_V(2); PG8_BAR;
        PG8_STAGE(PG8_SB(1, 0), cB + kstep, voffB); PG8_STAGE(PG8_SA(1, 0), cA + kstep, voffA); PG8_STAGE(PG8_SB(1, 1), cB + hstep + kstep, voffB);
        PG8_WAIT_V(6); PG8_BAR;
    } else {
        PG8_STAGE(PG8_SB(0, 0), cB, voffB); PG8_STAGE(PG8_SA(0, 0), cA, voffA); PG8_STAGE(PG8_SB(0, 1), cB + hstep, voffB); PG8_STAGE(PG8_SA(0, 1), cA + hstep, voffA);
        if (wr == 1) PG8_BAR;
        PG8_WAIT_V(4); PG8_BAR;
        PG8_STAGE(PG8_SB(1, 0), cB + kstep, voffB); PG8_STAGE(PG8_SA(1, 0), cA + kstep, voffA); PG8_STAGE(PG8_SB(1, 1), cB + hstep + kstep, voffB);
        PG8_WAIT_V(6); PG8_BAR;
    }
    for (;;) {
        const bool has_next = S.next(ui + 1, nxt);
        const char* nA = has_next ? (const char*)g.A + (size_t)nxt.pm * tstep : cA; const char* nB = has_next ? (const char*)g.Bt + (size_t)nxt.pn * tstep : cB;
#pragma unroll 1
        for (int t = 0; t < nt; t += 2) {
            const bool last = (t == nt - 2);
            const char* a1 = cA + (size_t)(t + 1) * kstep;
            const char* a2 = last ? nA : cA + (size_t)(t + 2) * kstep; const char* b2 = last ? nB : cB + (size_t)(t + 2) * kstep;
            const char* a3 = a2 + kstep; const char* b3 = b2 + kstep;
            if (last && has_next) S.a_ready(nxt);
            if constexpr (SP2) {
            PG8_LDB(B0, 0, 0); PG8_LDB(B1, 0, 1); PG8_SCHED; PG8_LDA(At, 0, 0); PG8_STAGE(PG8_SA(1, 1), a1 + hstep, voffA);
            PG8_WAIT_V(8); PG8_WAIT_L(0); PG8_BAR; PG8_MMA(0, 0, At, B0); PG8_MMA(0, 1, At, B1); PG8_BAR; PG8_SCHED;
            PG8_LDA(At, 0, 1); PG8_STAGE(PG8_SB(0, 0), b2, voffB); PG8_STAGE(PG8_SB(0, 1), b2 + hstep, voffB); PG8_STAGE(PG8_SA(0, 0), a2, voffA);
            PG8_WAIT_V(8); PG8_WAIT_L(0); PG8_BAR; PG8_MMA(1, 0, At, B0); PG8_MMA(1, 1, At, B1); PG8_BAR; PG8_SCHED;
            PG8_LDB(B0, 1, 0); PG8_LDB(B1, 1, 1); PG8_SCHED; PG8_LDA(At, 1, 0); PG8_STAGE(PG8_SA(0, 1), a2 + hstep, voffA);
            PG8_WAIT_V(8); PG8_WAIT_L(0); PG8_BAR; PG8_MMA(0, 0, At, B0); PG8_MMA(0, 1, At, B1); PG8_BAR; PG8_SCHED;
            PG8_LDA(At, 1, 1); PG8_STAGE(PG8_SB(1, 0), b3, voffB); PG8_STAGE(PG8_SB(1, 1), b3 + hstep, voffB); PG8_STAGE(PG8_SA(1, 0), a3, voffA);
            PG8_WAIT_V(8); PG8_WAIT_L(0); PG8_BAR; PG8_MMA(1, 0, At, B0); PG8_MMA(1, 1, At, B1); PG8_BAR; PG8_SCHED;
            } else {
            PG8_LDB(B0, 0, 0); PG8_SCHED; PG8_LDA(At, 0, 0); PG8_STAGE(PG8_SA(1, 1), a1 + hstep, voffA);
            PG8_WAIT_L(8); PG8_BAR; PG8_WAIT_L(0); PG8_MMA(0, 0, At, B0); PG8_BAR; PG8_SCHED;
            PG8_LDB(B1, 0, 1); PG8_STAGE(PG8_SB(0, 0), b2, voffB);
            PG8_BAR; PG8_WAIT_L(0); PG8_MMA(0, 1, At, B1); PG8_BAR;
            PG8_LDA(At, 0, 1); PG8_STAGE(PG8_SA(0, 0), a2, voffA);
            PG8_BAR; PG8_WAIT_L(0); PG8_MMA(1, 0, At, B0); PG8_BAR; PG8_SCHED;
            PG8_STAGE(PG8_SB(0, 1), b2 + hstep, voffB);
            PG8_WAIT_V(6); PG8_BAR; PG8_MMA(1, 1, At, B1); PG8_BAR;
            PG8_LDB(B0, 1, 0); PG8_SCHED; PG8_LDA(At, 1, 0); PG8_STAGE(PG8_SA(0, 1), a2 + hstep, voffA);
            PG8_WAIT_L(8); PG8_BAR; PG8_WAIT_L(0); PG8_MMA(0, 0, At, B0); PG8_BAR; PG8_SCHED;
            PG8_LDB(B1, 1, 1); PG8_STAGE(PG8_SB(1, 0), b3, voffB);
            PG8_BAR; PG8_WAIT_L(0); PG8_MMA(0, 1, At, B1); PG8_BAR;
            PG8_LDA(At, 1, 1); PG8_STAGE(PG8_SA(1, 0), a3, voffA);
            PG8_BAR; PG8_WAIT_L(0); PG8_MMA(1, 0, At, B0); PG8_BAR; PG8_SCHED;
            PG8_STAGE(PG8_SB(1, 1), b3 + hstep, voffB);
            PG8_WAIT_V(6); PG8_BAR; PG8_MMA(1, 1, At, B1); PG8_BAR;
            }
        }
        if constexpr (ALIGN_EPI) { if (wr == 0) PG8_BAR; }
        if constexpr (!Epi::AFTER_DRAIN) { E(acc, cur, wr, wc, fr, fq); S.done(cur); }
        if (!has_next) break;
#pragma unroll
        for (int a = 0; a < 2; ++a)
#pragma unroll
            for (int b = 0; b < 2; ++b)
#pragma unroll
                for (int m = 0; m < 4; ++m)
#pragma unroll
                    for (int n = 0; n < 2; ++n) acc[a][b][m][n] = (f32x4){0.f, 0.f, 0.f, 0.f};
        cur = nxt; cA = nA; cB = nB; ++ui;
        if constexpr (ALIGN_EPI) { if (wr == 1) PG8_BAR; }
    }
    PG8_WAIT_V(0);
    if constexpr (!ALIGN_EPI) { if (wr == 0) PG8_BAR; }
    PG8_BAR;
    if constexpr (Epi::AFTER_DRAIN) { E.fused(acc, cur, wr, wc, fr, fq, lds, wid, lane); S.done(cur); }
#undef PG8_SA
#undef PG8_SB
#undef PG8_STAGE
#undef PG8_LDA
#undef PG8_LDB
#undef PG8_MMA
#undef PG8_WAIT_V
#undef PG8_WAIT_L
#undef PG8_BAR
#undef PG8_SCHED
}
}
namespace att {
constexpr float SCALE = 0.6931471805599453f;
constexpr float THR = 8.f;
constexpr int SHM_V = 16384, SHM_K = 16384;
using bf16 = __hip_bfloat16;
typedef short bf16x8 __attribute__((ext_vector_type(8)));
typedef short s16x4 __attribute__((ext_vector_type(4)));
typedef float f32x16 __attribute__((ext_vector_type(16)));
typedef float f32x4 __attribute__((ext_vector_type(4)));
typedef unsigned u32x4 __attribute__((ext_vector_type(4)));
template <class A, class Bt> struct same_t { static constexpr bool v = false; };
template <class A> struct same_t<A, A> { static constexpr bool v = true; };

#define KSWZ(row, colB) ((row) * 256 + ((colB) ^ (((row) & 7) << 4)))
#define SBAR() __builtin_amdgcn_sched_barrier(0)
__device__ __forceinline__ int v_st(int k, int c) { const int kk = (k & ~0xC) | ((k & 4) << 1) | ((k & 8) >> 1); return ((kk >> 3) * 4 + (c >> 5)) * 512 + ((kk & 7) * 32 + (c & 31)) * 2; }
__device__ __forceinline__ int v_rd_base(int lane) { return ((lane & 3) << 3) | (((lane >> 2) & 3) << 6) | (((lane >> 4) & 1) << 5) | (((lane >> 5) & 1) << 8); }
constexpr int v_rd_off(int d0, int ks, int half) { return d0 * 512 + ks * 4096 + half * 2048; }
__device__ __forceinline__ int crow(int r, int hi) { return (r & 3) + 8 * (r >> 2) + 4 * hi; }
__device__ __forceinline__ unsigned cvtpk(float lo, float hi) {
    unsigned r; asm volatile("v_cvt_pk_bf16_f32 %0, %1, %2" : "=v"(r) : "v"(lo), "v"(hi)); return r;
}
__device__ __forceinline__ bf16x8 pack8(f32x4 a, f32x4 b) {
    u32x4 w = {cvtpk(a[0], a[1]), cvtpk(a[2], a[3]), cvtpk(b[0], b[1]), cvtpk(b[2], b[3])};
    return *reinterpret_cast<bf16x8*>(&w);
}
template <class T> __device__ __forceinline__ bf16x8 load8(const T* p) {
    if constexpr (same_t<T, float>::v) { return pack8(*(const f32x4*)p, *(const f32x4*)(p + 4)); }
    else { return *reinterpret_cast<const bf16x8*>(p); }
}
__device__ __forceinline__ void mask_tile(f32x16& p0, f32x16& p1, int dq, unsigned W) {
    const float NEG = -__builtin_inff();
#pragma unroll
    for (int r = 0; r < 16; ++r) {
        const int c = (r & 3) + 8 * (r >> 2);
        if ((unsigned)(dq - c) >= W) p0[r] = NEG;
        if ((unsigned)(dq - c - 32) >= W) p1[r] = NEG;
    }
}
__device__ __forceinline__ void partialSM(f32x16& p0, f32x16& p1, float& m_reg, float& mn, float& alpha) {
    float pmax = p0[0]; for (int r = 1; r < 16; ++r) pmax = fmaxf(pmax, p0[r]); for (int r = 0; r < 16; ++r) pmax = fmaxf(pmax, p1[r]);
    { auto rr = __builtin_amdgcn_permlane32_swap(__float_as_uint(pmax), __float_as_uint(pmax), false, false);
      pmax = fmaxf(__uint_as_float(rr[0]), __uint_as_float(rr[1])); }
    constexpr float C2 = 1.4426950408889634f * SCALE;
    if (__builtin_expect(__all((pmax - m_reg) * SCALE <= THR), 1)) { mn = m_reg; alpha = 1.f; }
    else { mn = fmaxf(m_reg, pmax); alpha = __builtin_amdgcn_exp2f((m_reg - mn) * C2); m_reg = mn; }
    const float mnL = -mn * C2;
    for (int r = 0; r < 16; ++r) p0[r] = fmaf(p0[r], C2, mnL); for (int r = 0; r < 16; ++r) p1[r] = fmaf(p1[r], C2, mnL);
    for (int r = 0; r < 16; ++r) p0[r] = __builtin_amdgcn_exp2f(p0[r]);
}
__device__ __forceinline__ void finishSM(f32x16& p0, f32x16& p1, float alpha, float& l_reg, bf16x8& pa0, bf16x8& pa1, bf16x8& pa2, bf16x8& pa3) {
    for (int r = 0; r < 16; ++r) p1[r] = __builtin_amdgcn_exp2f(p1[r]);
    float ps = 0; for (int r = 0; r < 16; ++r) ps += p0[r]; for (int r = 0; r < 16; ++r) ps += p1[r];
    { auto rr = __builtin_amdgcn_permlane32_swap(__float_as_uint(ps), __float_as_uint(ps), false, false);
      ps = __uint_as_float(rr[0]) + __uint_as_float(rr[1]); }
    l_reg = l_reg * alpha + ps;
#define PK4(P, B_, OUT) do { unsigned a0 = cvtpk(P[B_+0], P[B_+1]), a1 = cvtpk(P[B_+2], P[B_+3]);                          \
        unsigned b0 = cvtpk(P[B_+4], P[B_+5]), b1 = cvtpk(P[B_+6], P[B_+7]);                                             \
        auto r0 = __builtin_amdgcn_permlane32_swap(a0, b0, false, false); auto r1 = __builtin_amdgcn_permlane32_swap(a1, b1, false, false); \
        u32x4 w = {r0[0], r1[0], r0[1], r1[1]}; OUT = *reinterpret_cast<bf16x8*>(&w); } while (0)
    PK4(p0, 0, pa0); PK4(p0, 8, pa1); PK4(p1, 0, pa2); PK4(p1, 8, pa3);
#undef PK4
}
template <int VB, bool SK>
__device__ __forceinline__ void pv_tile(f32x16* o, int vb0, bf16x8 pa0, bf16x8 pa1, bf16x8 pa2, bf16x8 pa3, bool act) {
    if (SK && !act) return;
#define TRRD(dst, off) asm volatile("ds_read_b64_tr_b16 %0, %1 offset:%2" : "=&v"(dst) : "v"(vb0), "i"(off) : "memory")
#define PV_D0(d0) do { s16x4 l0, l1, l2, l3, h0, h1, h2, h3; constexpr int b_ = VB * SHM_V + v_rd_off(d0, 0, 0);     \
        TRRD(l0, b_); TRRD(h0, b_ + 2048); TRRD(l1, b_ + 4096); TRRD(h1, b_ + 6144); TRRD(l2, b_ + 8192); TRRD(h2, b_ + 10240); TRRD(l3, b_ + 12288); TRRD(h3, b_ + 14336); \
        asm volatile("s_waitcnt lgkmcnt(0)" ::: "memory"); SBAR();                 \
        o[d0] = __builtin_amdgcn_mfma_f32_32x32x16_bf16(pa0, (bf16x8){l0[0], l0[1], l0[2], l0[3], h0[0], h0[1], h0[2], h0[3]}, o[d0], 0, 0, 0);   \
        o[d0] = __builtin_amdgcn_mfma_f32_32x32x16_bf16(pa1, (bf16x8){l1[0], l1[1], l1[2], l1[3], h1[0], h1[1], h1[2], h1[3]}, o[d0], 0, 0, 0);   \
        o[d0] = __builtin_amdgcn_mfma_f32_32x32x16_bf16(pa2, (bf16x8){l2[0], l2[1], l2[2], l2[3], h2[0], h2[1], h2[2], h2[3]}, o[d0], 0, 0, 0);   \
        o[d0] = __builtin_amdgcn_mfma_f32_32x32x16_bf16(pa3, (bf16x8){l3[0], l3[1], l3[2], l3[3], h3[0], h3[1], h3[2], h3[3]}, o[d0], 0, 0, 0); } while (0)
    PV_D0(0); PV_D0(1); PV_D0(2); PV_D0(3);
#undef PV_D0
#undef TRRD
}

template <int VB>
__device__ __forceinline__ void pv_tile2(f32x16* o, int vb0, bf16x8 pa0, bf16x8 pa1, bf16x8 pa2, bf16x8 pa3) {
#define TRRD(dst, off) asm volatile("ds_read_b64_tr_b16 %0, %1 offset:%2" : "=&v"(dst) : "v"(vb0), "i"(off) : "memory")
#define PV_RD(S, d0) do { constexpr int b_ = VB * SHM_V + v_rd_off(d0, 0, 0); \
        TRRD(l0##S, b_); TRRD(h0##S, b_ + 2048); TRRD(l1##S, b_ + 4096); TRRD(h1##S, b_ + 6144); TRRD(l2##S, b_ + 8192); TRRD(h2##S, b_ + 10240); TRRD(l3##S, b_ + 12288); TRRD(h3##S, b_ + 14336); } while (0)
#define PV_MM(S, d0) do { \
        o[d0] = __builtin_amdgcn_mfma_f32_32x32x16_bf16(pa0, (bf16x8){l0##S[0], l0##S[1], l0##S[2], l0##S[3], h0##S[0], h0##S[1], h0##S[2], h0##S[3]}, o[d0], 0, 0, 0);   \
        o[d0] = __builtin_amdgcn_mfma_f32_32x32x16_bf16(pa1, (bf16x8){l1##S[0], l1##S[1], l1##S[2], l1##S[3], h1##S[0], h1##S[1], h1##S[2], h1##S[3]}, o[d0], 0, 0, 0);   \
        o[d0] = __builtin_amdgcn_mfma_f32_32x32x16_bf16(pa2, (bf16x8){l2##S[0], l2##S[1], l2##S[2], l2##S[3], h2##S[0], h2##S[1], h2##S[2], h2##S[3]}, o[d0], 0, 0, 0);   \
        o[d0] = __builtin_amdgcn_mfma_f32_32x32x16_bf16(pa3, (bf16x8){l3##S[0], l3##S[1], l3##S[2], l3##S[3], h3##S[0], h3##S[1], h3##S[2], h3##S[3]}, o[d0], 0, 0, 0); } while (0)
    s16x4 l0a, l1a, l2a, l3a, h0a, h1a, h2a, h3a, l0b, l1b, l2b, l3b, h0b, h1b, h2b, h3b;
    PV_RD(a, 0); PV_RD(b, 1);
    asm volatile("s_waitcnt lgkmcnt(8)" ::: "memory"); SBAR(); PV_MM(a, 0); SBAR();
    PV_RD(a, 2);
    asm volatile("s_waitcnt lgkmcnt(8)" ::: "memory"); SBAR(); PV_MM(b, 1); SBAR();
    PV_RD(b, 3);
    asm volatile("s_waitcnt lgkmcnt(8)" ::: "memory"); SBAR(); PV_MM(a, 2); SBAR();
    asm volatile("s_waitcnt lgkmcnt(0)" ::: "memory"); SBAR(); PV_MM(b, 3);
#undef PV_MM
#undef PV_RD
#undef TRRD
}
template <int KB, bool HALFB>
__device__ __forceinline__ void qkt128(f32x16& p0, f32x16& p1, const char* K_lds, int r32, int hi, const bf16x8* qr, const f32x16& cinit) {
    const char* kb[4];
#pragma unroll
    for (int dd = 0; dd < 4; ++dd) kb[dd] = K_lds + KB * SHM_K + KSWZ(r32, (dd * 16 + hi * 8) * 2) + ((r32 >> 3) & 1) * 128;
    const int kdl = ((r32 >> 3) & 1) ? -128 : 128;
    if (HALFB) {
#pragma unroll
        for (int hb = 0; hb < 2; ++hb) { bf16x8 kf[8];
#pragma unroll
            for (int d = 0; d < 4; ++d) { const int d0 = hb * 4 + d; const char* a = kb[d0 & 3] + (d0 >> 2) * kdl;
                kf[2 * d] = *reinterpret_cast<const bf16x8*>(a); kf[2 * d + 1] = *reinterpret_cast<const bf16x8*>(a + 32 * 256); }
            SBAR();
#pragma unroll
            for (int d = 0; d < 4; ++d) { const int d0 = hb * 4 + d;
                p0 = __builtin_amdgcn_mfma_f32_32x32x16_bf16(kf[2 * d], qr[d0], d0 == 0 ? cinit : p0, 0, 0, 0);
                p1 = __builtin_amdgcn_mfma_f32_32x32x16_bf16(kf[2 * d + 1], qr[d0], d0 == 0 ? cinit : p1, 0, 0, 0); }
            SBAR(); }
    } else {
    bf16x8 kf[16];
#pragma unroll
    for (int d0 = 0; d0 < 8; ++d0) { const char* a = kb[d0 & 3] + (d0 >> 2) * kdl;
        kf[2 * d0] = *reinterpret_cast<const bf16x8*>(a); kf[2 * d0 + 1] = *reinterpret_cast<const bf16x8*>(a + 32 * 256); }
    SBAR();
#pragma unroll
    for (int d0 = 0; d0 < 8; ++d0) {
        p0 = __builtin_amdgcn_mfma_f32_32x32x16_bf16(kf[2 * d0], qr[d0], d0 == 0 ? cinit : p0, 0, 0, 0);
        p1 = __builtin_amdgcn_mfma_f32_32x32x16_bf16(kf[2 * d0 + 1], qr[d0], d0 == 0 ? cinit : p1, 0, 0, 0); }
    }
}
#define KSWZ64(row, colB) ((row) * 128 + ((colB) ^ (((row) & 7) << 4)))
template <int KB>
__device__ __forceinline__ void qkt64(f32x16& p0, f32x16& p1, const char* K_lds, int r32, int hi, const bf16x8* qr, const f32x16& cinit) {
    const int prow = (r32 & ~1) | ((r32 & 1) ^ ((r32 >> 3) & 1));
#pragma unroll
    for (int hb = 0; hb < 2; ++hb) { bf16x8 kf[4];
#pragma unroll
        for (int d = 0; d < 2; ++d) { const int d0 = hb * 2 + d; const char* a = K_lds + KB * SHM_K + prow * 128 + (((d0 * 16 + hi * 8) * 2) ^ ((r32 & 7) << 4));
            kf[2 * d] = *reinterpret_cast<const bf16x8*>(a); kf[2 * d + 1] = *reinterpret_cast<const bf16x8*>(a + 32 * 128); }
        SBAR();
#pragma unroll
        for (int d = 0; d < 2; ++d) { const int d0 = hb * 2 + d;
            p0 = __builtin_amdgcn_mfma_f32_32x32x16_bf16(kf[2 * d], qr[d0], d0 == 0 ? cinit : p0, 0, 0, 0);
            p1 = __builtin_amdgcn_mfma_f32_32x32x16_bf16(kf[2 * d + 1], qr[d0], d0 == 0 ? cinit : p1, 0, 0, 0); }
        SBAR(); }
}
__device__ __forceinline__ void partialSM2(f32x16& p0, f32x16& p1, float& m_ref, f32x16& negm, float& alpha) {
    float pmax = p0[0]; for (int r = 1; r < 16; ++r) pmax = fmaxf(pmax, p0[r]); for (int r = 0; r < 16; ++r) pmax = fmaxf(pmax, p1[r]);
    { auto rr = __builtin_amdgcn_permlane32_swap(__float_as_uint(pmax), __float_as_uint(pmax), false, false);
      pmax = fmaxf(__uint_as_float(rr[0]), __uint_as_float(rr[1])); }
    constexpr float THR2 = THR * 1.4426950408889634f;
    if (__builtin_expect(__all(pmax <= THR2), 1)) { alpha = 1.f; }
    else { const float dl = fmaxf(pmax, 0.f); m_ref += dl; alpha = __builtin_amdgcn_exp2f(-dl);
        for (int r = 0; r < 16; ++r) { p0[r] -= dl; p1[r] -= dl; }
        for (int r = 0; r < 16; ++r) negm[r] = -m_ref; }
    for (int r = 0; r < 16; ++r) p0[r] = __builtin_amdgcn_exp2f(p0[r]);
}
typedef unsigned short bfr;
constexpr int LDS_K = 0, LDS_V = 65536, LDS_WS = 131072, LDS_CK = 131072 + 2048, ATT_LDS = LDS_CK + 768;
struct Unit {
    const bfr* Q; const bfr* K; const bfr* V;
    long stride;
    int q0;
    int j_lo, j_hi;
    int W;
    const float* c;
};
__device__ __forceinline__ void normalize_o(f32x16 (&o)[4], float l_reg, char* lds, int wid, int r32, int hi);
__device__ __forceinline__ float* stage_o(f32x16 (&o)[4], char* lds, int wid, int ln);
#define ATT_LAS __attribute__((address_space(3)))
#ifdef PV_SINGLE
#define PVT(o_, vb_, a0, a1, a2, a3) pv_tile<0, false>(o_, vb_, a0, a1, a2, a3, true)
#else
#define PVT(o_, vb_, a0, a1, a2, a3) pv_tile2<0>(o_, vb_, a0, a1, a2, a3)
#endif
#ifndef NEGM_SEL
#define NEGM_SEL(DQK, FOX, SKIP) (!(FOX))
#endif
template <int DQK, bool FOX, bool SKIP>
__device__ __forceinline__ void unit_core(const Unit& U, char* lds, f32x16 (&o)[4], float& m_reg, float& l_reg,
                                          bf16x8 (&qr)[8], bool have_q, const bfr* nQ, long nstride, int nq0, int nfr) {
    int tid_l = threadIdx.x; asm volatile("" : "+v"(tid_l));
    const int tid = tid_l, wid = __builtin_amdgcn_readfirstlane(tid >> 6), lane = tid & 63, r32 = lane & 31, hi = lane >> 5;
    char* V_lds = lds + LDS_V; char* K_lds = lds + LDS_K;
    ATT_LAS unsigned char* lds3 = (ATT_LAS unsigned char*)(unsigned)(uintptr_t)lds;
    float* ws = (float*)(lds + LDS_WS) + wid * 64; float* al_l = ws + 32;
    float* ckl = (float*)(lds + LDS_CK);
    const int NT = U.j_hi - U.j_lo;
    const int qlo = U.q0 + wid * 32, qm = qlo + r32 - 4 * hi;
    int voff[2];
#pragma unroll
    for (int i = 0; i < 2; ++i) { const int p = (2 * wid + i) * 64 + lane, st = p >> 5, wi = p & 31, kk = (st >> 2) * 8 + (wi >> 2);
        const int key = (kk & ~0xC) | ((kk & 4) << 1) | ((kk & 8) >> 1); voff[i] = key * (int)U.stride + (st & 3) * 32 + (wi & 3) * 8; }
    int koff[2];
    if (DQK == 128) {
#pragma unroll
        for (int i = 0; i < 2; ++i) { const int p = (2 * wid + i) * 64 + lane, row = p >> 4, c = (p & 15) ^ ((row & 7) | (((row >> 3) & 1) << 3)); koff[i] = row * (int)U.stride + c * 8; }
    } else { const int p = wid * 64 + lane, prow = p >> 3, row = (prow & ~1) | ((prow & 1) ^ ((prow >> 3) & 1)), c = (p & 7) ^ (row & 7); koff[0] = row * (int)U.stride + c * 8; koff[1] = 0; }
    const long tstep = 64 * U.stride;
#define A_TIDX(t_) (FOX ? (U.j_hi - 1 - (t_)) : (U.j_lo + (t_)))
#define A_DMA_K(t_, kslot) do { const long tb__ = (long)A_TIDX(t_) * tstep; \
        if (DQK == 128) { _Pragma("unroll") for (int i = 0; i < 2; ++i) \
            __builtin_amdgcn_global_load_lds((const unsigned*)(U.K + tb__ + koff[i]), (ATT_LAS unsigned*)(lds3 + LDS_K + (kslot) * SHM_K + (2 * wid + i) * 1024), 16, 0, 0); } \
        else __builtin_amdgcn_global_load_lds((const unsigned*)(U.K + tb__ + koff[0]), (ATT_LAS unsigned*)(lds3 + LDS_K + (kslot) * SHM_K + wid * 1024), 16, 0, 0); } while (0)
#define A_DMA_V(t_, vslot, cslot) do { const long tb__ = (long)A_TIDX(t_) * tstep; \
        _Pragma("unroll") for (int i = 0; i < 2; ++i) \
            __builtin_amdgcn_global_load_lds((const unsigned*)(U.V + tb__ + voff[i]), (ATT_LAS unsigned*)(lds3 + LDS_V + (vslot) * SHM_V + (2 * wid + i) * 1024), 16, 0, 0); \
        if (FOX) { if (wid == 0) __builtin_amdgcn_global_load_lds((const unsigned*)(U.c + (long)A_TIDX(t_) * 64 + lane), (ATT_LAS unsigned*)(lds3 + LDS_CK + (cslot) * 256), 4, 0, 0); } } while (0)
#define A_DMA_VONLY(t_, vslot) do { const long tb__ = (long)A_TIDX(t_) * tstep; \
        _Pragma("unroll") for (int i = 0; i < 2; ++i) \
            __builtin_amdgcn_global_load_lds((const unsigned*)(U.V + tb__ + voff[i]), (ATT_LAS unsigned*)(lds3 + LDS_V + (vslot) * SHM_V + (2 * wid + i) * 1024), 16, 0, 0); } while (0)
#define A_DMA_CK(t_, cslot) do { if (FOX) { if (wid == 0) __builtin_amdgcn_global_load_lds((const unsigned*)(U.c + (long)A_TIDX(t_) * 64 + lane), (ATT_LAS unsigned*)(lds3 + LDS_CK + (cslot) * 256), 4, 0, 0); } } while (0)
#define A_ISSUE(t_) do { if ((t_) + 3 < NT) A_DMA_K((t_) + 3, (vc + 3) & 3); if ((t_) + 2 < NT) A_DMA_V((t_) + 2, (vc + 2) & 3, A_K2()); } while (0)
#define A_VMW(n) asm volatile("s_waitcnt vmcnt(" #n ") lgkmcnt(0)" ::: "memory")
#define A_WAITBAR(t_) do { const bool ik_ = (t_) + 3 < NT, iv_ = (t_) + 2 < NT; const bool w0_ = FOX && wid == 0; \
        if (ik_) { if (DQK == 128) { if (w0_) A_VMW(5); else A_VMW(4); } else { if (w0_) A_VMW(4); else A_VMW(3); } } \
        else if (iv_) { if (w0_) A_VMW(3); else A_VMW(2); } \
        else A_VMW(0); \
        __builtin_amdgcn_s_barrier(); asm volatile("" ::: "memory"); } while (0)
    if (!have_q) { const bfr* qp = U.Q + (long)(qlo + r32) * U.stride + hi * 8;
#pragma unroll
      for (int d0 = 0; d0 < DQK / 16; ++d0) qr[d0] = *reinterpret_cast<const bf16x8*>(qp + d0 * 16); }
    if (SKIP) { A_DMA_K(0, 0); A_DMA_VONLY(0, 0); } else { A_DMA_CK(0, 0); A_DMA_K(0, 0); A_DMA_VONLY(0, 0); }
    if (NT > 1) { A_DMA_K(1, 1); A_DMA_V(1, 1, 1); } if (NT > 2) A_DMA_K(2, 2);
#define A_QPF() do { if (nfr) { const bfr* qp_ = nQ + (long)(nq0 + wid * 32 + r32) * nstride + hi * 8; \
        _Pragma("unroll") for (int d0 = 0; d0 < 8; ++d0) { if (d0 < nfr) qr[d0] = *reinterpret_cast<const bf16x8*>(qp_ + d0 * 16); } } } while (0)
    float cqv = 0.f; if (FOX) cqv = U.c[qlo + r32];
    constexpr bool NEGM = NEGM_SEL(DQK, FOX, SKIP);
    m_reg = !NEGM ? -1e30f : 0.f; l_reg = 0.f;
    f32x16 negm = f32x16{};
#pragma unroll
    for (int d = 0; d < 4; ++d) o[d] = f32x16{};
    const int vb0 = (int)(uintptr_t)V_lds + v_rd_base(lane);
    { const bool w0_ = FOX && wid == 0;
      if (SKIP) { if (NT > 2) A_VMW(6); else if (NT > 1) A_VMW(4); else A_VMW(0); }
      else if (DQK == 128) { if (NT > 2) { if (w0_) A_VMW(9); else A_VMW(8); } else if (NT > 1) { if (w0_) A_VMW(7); else A_VMW(6); } else A_VMW(2); }
      else { if (NT > 2) A_VMW(6); else if (NT > 1) A_VMW(5); else A_VMW(2); }
      __builtin_amdgcn_s_barrier(); asm volatile("" ::: "memory"); }
    f32x16 pA0, pA1, pB0, pB1; bf16x8 pa0, pa1, pa2, pa3; float mnA = 0.f, mnB = 0.f, alA = 1.f, alB = 1.f; bool actA = false, actB = false;
    int kc = 0, vc = 0;
#define A_ACT(t_) (!SKIP || (((A_TIDX(t_) * 64 <= qlo + 31) && (A_TIDX(t_) * 64 + 63 + U.W > qlo))))
#define A_HEADS(PX0, PX1, mnX, alX, actX, t_, ks_) do { actX = A_ACT(t_); alX = 1.f; \
        if (!SKIP || actX) { \
            if (DQK == 128) qkt128<0, true>(PX0, PX1, K_lds + (ks_) * SHM_K, r32, hi, qr, negm); else qkt64<0>(PX0, PX1, K_lds + (ks_) * SHM_K, r32, hi, qr, negm); } } while (0)
#define A_HEAD(PX0, PX1, mnX, alX, actX, t_) A_HEADS(PX0, PX1, mnX, alX, actX, t_, vc)
#define A_SOFT1(PX0, PX1, mnX, alX, actX, t_) do { const int kb_ = A_TIDX(t_) * 64; \
        if (!SKIP || actX) { \
            if (FOX) { const float* ck_ = ckl + kc * 64 + 4 * hi; \
                _Pragma("unroll") for (int g = 0; g < 4; ++g) { const f32x4 c0 = *(const f32x4*)(ck_ + 8 * g); const f32x4 c1 = *(const f32x4*)(ck_ + 32 + 8 * g); \
                    _Pragma("unroll") for (int i = 0; i < 4; ++i) { PX0[4 * g + i] += cqv - c0[i]; PX1[4 * g + i] += cqv - c1[i]; } } } \
            if (kb_ + 63 > qlo || kb_ + U.W <= qlo + 31) mask_tile(PX0, PX1, qm - kb_, (unsigned)U.W); \
            if (!NEGM) partialSM(PX0, PX1, m_reg, mnX, alX); else partialSM2(PX0, PX1, m_reg, negm, alX); } } while (0)
#define A_TAIL(PY0, PY1, alY, actY, vslot) do { if (!SKIP || actY) { finishSM(PY0, PY1, alY, l_reg, pa0, pa1, pa2, pa3); SBAR(); PVT(o, vb0 + (vslot) * SHM_V, pa0, pa1, pa2, pa3); } } while (0)
#define A_RESC(alX) do { if (__any((alX) < 1.f)) { if (hi == 0) al_l[r32] = (alX); asm volatile("s_waitcnt lgkmcnt(0)" ::: "memory"); \
        _Pragma("unroll") for (int d_ = 0; d_ < 4; ++d_) _Pragma("unroll") for (int r = 0; r < 16; ++r) o[d_][r] *= al_l[crow(r, hi)]; } } while (0)
#define A_ROT() do { kc = (kc == 2) ? 0 : kc + 1; vc = (vc + 1) & 3; } while (0)
#define A_K2() ((kc == 0) ? 2 : kc - 1)
    if (SKIP) {
        for (int ts = 0; ts < NT; ++ts) {
            A_ISSUE(ts);
            if (A_ACT(ts)) { actA = true; A_HEAD(pA0, pA1, mnA, alA, actA, ts); A_SOFT1(pA0, pA1, mnA, alA, actA, ts); A_RESC(alA);
                finishSM(pA0, pA1, alA, l_reg, pa0, pa1, pa2, pa3); SBAR(); PVT(o, vb0 + vc * SHM_V, pa0, pa1, pa2, pa3); }
            A_WAITBAR(ts); A_ROT(); }
        A_QPF();
        normalize_o(o, l_reg, lds, wid, r32, hi); { int ln_ = lane; asm volatile("" : "+v"(ln_)); stage_o(o, lds, wid, ln_); }
        return;
    }
#define A_STEP_AB(PX0, PX1, mnX, alX, actX, PY0, PY1, mnY, alY, actY, t_) do { const int t__ = (t_); \
        A_ISSUE(t__); \
        SBAR(); if (grpA) { A_HEAD(PX0, PX1, mnX, alX, actX, t__); } SBAR(); \
        A_TAIL(PY0, PY1, alY, actY, (vc + 3) & 3); \
        A_SOFT1(PX0, PX1, mnX, alX, actX, t__); \
        A_RESC(alX); SBAR(); \
        if (!grpA && t__ + 1 < NT) { A_HEADS(PY0, PY1, mnY, alY, actY, t__ + 1, (vc + 1) & 3); } \
        A_WAITBAR(t__); A_ROT(); } while (0)
#define A_LOOP(STEPM) do { int t = 1; \
        for (; t + 1 < NT; t += 2) { \
            STEPM(pB0, pB1, mnB, alB, actB, pA0, pA1, mnA, alA, actA, t); \
            STEPM(pA0, pA1, mnA, alA, actA, pB0, pB1, mnB, alB, actB, t + 1); } \
        if (t < NT) { STEPM(pB0, pB1, mnB, alB, actB, pA0, pA1, mnA, alA, actA, t); pA0 = pB0; pA1 = pB1; alA = alB; actA = actB; } \
        A_QPF(); A_TAIL(pA0, pA1, alA, actA, (vc + 3) & 3); } while (0)
#define A_FIN() do { asm volatile("s_waitcnt lgkmcnt(0)" ::: "memory"); __builtin_amdgcn_s_barrier(); asm volatile("" ::: "memory"); \
        normalize_o(o, l_reg, lds, wid, r32, hi); { int ln_ = lane; asm volatile("" : "+v"(ln_)); stage_o(o, lds, wid, ln_); } } while (0)
    const bool grpA = true;
    { A_ISSUE(0);
      A_HEAD(pA0, pA1, mnA, alA, actA, 0); A_SOFT1(pA0, pA1, mnA, alA, actA, 0); SBAR();
      if (!grpA && NT > 1) { A_HEADS(pB0, pB1, mnB, alB, actB, 1, 1); }
      A_WAITBAR(0); A_ROT(); }
    A_LOOP(A_STEP_AB); A_FIN();
    return;
#undef A_FIN
#undef A_QPF
#undef A_LOOP
#undef A_STEP_AB
#undef A_K2
#undef A_ROT
#undef A_RESC
#undef A_TAIL
#undef A_SOFT1
#undef A_HEAD
#undef A_HEADS
#undef A_ACT
#undef A_WAITBAR
#undef A_ISSUE
#undef A_TIDX
#undef A_DMA_K
#undef A_DMA_V
#undef A_DMA_VONLY
#undef A_DMA_CK
#undef A_VMW
}
__device__ __forceinline__ void normalize_o(f32x16 (&o)[4], float l_reg, char* lds, int wid, int r32, int hi) {
    float* li_l = (float*)(lds + LDS_WS) + wid * 64;
    if (hi == 0) li_l[r32] = l_reg; asm volatile("s_waitcnt lgkmcnt(0)" ::: "memory");
#pragma unroll
    for (int r = 0; r < 16; ++r) { const float rl = __builtin_amdgcn_rcpf(li_l[crow(r, hi)]);
#pragma unroll
        for (int d = 0; d < 4; ++d) o[d][r] *= rl; }
    asm volatile("s_waitcnt lgkmcnt(0)" ::: "memory");
}
__device__ __forceinline__ float* stage_o(f32x16 (&o)[4], char* lds, int wid, int ln) {
    float* stg = (float*)(lds + wid * 16384);
    float* wb = stg + (ln >> 5) * 512 + (ln & 31);
#pragma unroll
    for (int r = 0; r < 16; ++r)
#pragma unroll
        for (int d0 = 0; d0 < 4; ++d0) wb[((r & 3) + 8 * (r >> 2)) * 128 + d0 * 32] = o[d0][r];
    asm volatile("s_waitcnt lgkmcnt(0)" ::: "memory");
    return stg;
}
__device__ __forceinline__ f32x4 stg_chunk(const float* stg, int row, int half, int j) { return *(const f32x4*)(stg + row * 128 + half * 64 + 4 * j); }
}
constexpr int BATCH = 8, SEQ = 4096, DM = 1024, TOK = BATCH * SEQ, PLE = 256, EVEN_IN = 4100, NPROJ = 4096;
constexpr float RMS_EPS = 1e-6f, LAM_INIT0 = 0.2f;
constexpr size_t MiB = 1u << 20;
constexpr size_t WS_RSTD0 = 0, WS_LF = 256 * 1024, WS_C = 1 * MiB, WS_SSQ = 2 * MiB, WS_LSE = 4 * MiB, WS_BAR = 7 * MiB, BAR_BYTES = 16384;
constexpr size_t WS_W0T = 8 * MiB, WS_W1T = 16 * MiB, WS_WO0T = 24 * MiB, WS_WO1T = 26 * MiB, WS_WG0T = 28 * MiB, WS_WG1T = 30 * MiB, WS_WP0T = 32 * MiB, WS_WP1T = 32 * MiB + 512 * 1024;
constexpr size_t WS_PB = 34 * MiB, WS_A = 50 * MiB, WS_B = 114 * MiB, WS_CC = 178 * MiB, WS_PROJ = 242 * MiB, WS_ROPE = 498 * MiB, WS_END = 502 * MiB;
constexpr int LDS_BYTES = 147456, LDS_XCH = 135168;
typedef unsigned short bfr;
typedef float f32x4 __attribute__((ext_vector_type(4)));
typedef unsigned u32x4 __attribute__((ext_vector_type(4)));
typedef unsigned u32x2 __attribute__((ext_vector_type(2)));

struct Params {
    const float* x; const float* p; const int* positions; const float* norm_g; const float* w_in_even; const float* b_forget;
    const float* qn_a; const float* kn_a; const float* qn_b; const float* kn_b; const float* lam_q1; const float* lam_k1; const float* lam_q2; const float* lam_k2;
    const float* subln_g; const float* w_out_even; const float* w_in_odd; const float* qn_c; const float* kn_c; const float* w_out_odd; const float* w_ple; const float* w_ple_gate;
    float* out; unsigned char* ws;
};

__device__ __forceinline__ unsigned cvtpk(float lo, float hi) { unsigned r; asm volatile("v_cvt_pk_bf16_f32 %0, %1, %2" : "=v"(r) : "v"(lo), "v"(hi)); return r; }
__device__ __forceinline__ float bf2f(unsigned short b) { return __uint_as_float((unsigned)b << 16); }
__device__ __forceinline__ float shx(float v, int mask, int ln) { return __int_as_float(__builtin_amdgcn_ds_bpermute((ln ^ mask) << 2, __float_as_int(v))); }
__device__ __forceinline__ float wave_sum(float v, int ln) {
#pragma unroll
    for (int o = 1; o < 64; o <<= 1) v += shx(v, o, ln);
    return v;
}
__device__ __forceinline__ float silu_f(float z) { return z / (1.f + __expf(-z)); }
#ifdef V_FASTSIG
__device__ __forceinline__ float sigmoid_f(float z) { return __builtin_amdgcn_rcpf(1.f + __builtin_amdgcn_exp2f(-1.4426950408889634f * z)); }
#else
__device__ __forceinline__ float sigmoid_f(float z) { return 1.f / (1.f + __expf(-z)); }
#endif

struct EpiProj {
    static constexpr bool PERM = true, AFTER_DRAIN = false;
    bfr* O; int ldc; const float* rstd; const float* ssqp;
    __device__ __forceinline__ void operator()(const pg8::f32x4 (&acc)[2][2][4][2], const pg8::Unit& u, int wr, int wc, int fr, int fq) const {
        int fr_ = fr, fq_ = fq; asm volatile("" : "+v"(fr_), "+v"(fq_));
        const int row0 = u.pm * 256 + wr * 64 + fr_;
        bfr* Ob = O + (size_t)u.pm * 256 * ldc + u.pn * 256; const unsigned loff = (unsigned)(wr * 64 + fr_) * (unsigned)ldc + (unsigned)(wc * 32 + 8 * fq_);
#pragma unroll
        for (int ai = 0; ai < 2; ++ai)
#pragma unroll
            for (int m = 0; m < 4; ++m) { const int row = row0 + ai * 128 + m * 16; float rs;
                if (ssqp) { const f32x4* sp = (const f32x4*)(ssqp + (unsigned)row * 16u); const f32x4 a = sp[0], b = sp[1], c = sp[2], d = sp[3];
                    const float s = ((a[0] + a[1]) + (a[2] + a[3])) + ((b[0] + b[1]) + (b[2] + b[3])) + ((c[0] + c[1]) + (c[2] + c[3])) + ((d[0] + d[1]) + (d[2] + d[3]));
                    rs = __builtin_amdgcn_rsqf(s * (1.f / 1024.f) + RMS_EPS); }
                else rs = rstd[row];
                bfr* rowp = Ob + (loff + (unsigned)(ai * 128 + m * 16) * (unsigned)ldc);
#pragma unroll
                for (int bj = 0; bj < 2; ++bj) { const pg8::f32x4 v0 = acc[ai][bj][m][0] * rs, v1 = acc[ai][bj][m][1] * rs;
                    u32x4 w; w.x = cvtpk(v0[0], v0[1]); w.y = cvtpk(v0[2], v0[3]); w.z = cvtpk(v1[0], v1[1]); w.w = cvtpk(v1[2], v1[3]);
                    *(u32x4*)(rowp + bj * 128) = w; }
                asm volatile("" ::: "memory"); }
    }
};
template <int LAYER>
struct EpiProjNR {
    static constexpr bool PERM = true, AFTER_DRAIN = false;
    bfr* O; const float* rstd; const float* ssqp; const float* rope; const float* g_q64; const float* g_k64; const float* g_q128; const float* g_k128; float* xch;
    __device__ __forceinline__ void operator()(const pg8::f32x4 (&acc)[2][2][4][2], const pg8::Unit& u, int wr, int wc, int fr, int fq) const {
        int fr_ = fr, fq_ = fq; asm volatile("" : "+v"(fr_), "+v"(fq_));
        const int ln = fq_ * 16 + fr_, rl0 = wr * 64 + fr_, row0 = u.pm * 256 + rl0;
        int gw = 0; const float* gain = nullptr; float scale = 1.f; bool rope_t = false;
        if (LAYER == 0) {
            if (u.pn < 2) { gw = 64; gain = g_q64; scale = 0.125f * 1.4426950408889634f; rope_t = true; }
            else if (u.pn < 4) { gw = 64; gain = g_k64; rope_t = true; }
            else if (u.pn == 6 || u.pn == 7) { gw = 128; gain = g_q128; scale = 0.08838834764831845f * 1.4426950408889634f; }
            else if (u.pn == 8 || u.pn == 9) { gw = 128; gain = g_k128; }
        } else {
            if (u.pn < 4) { gw = 128; gain = g_q128; scale = 0.08838834764831845f * 1.4426950408889634f; rope_t = true; }
            else if (u.pn < 8) { gw = 128; gain = g_k128; rope_t = true; }
        }
        bfr* Ob = O + (size_t)u.pm * 256 * NPROJ + u.pn * 256; const unsigned loff = (unsigned)rl0 * (unsigned)NPROJ + (unsigned)(wc * 32 + 8 * fq_);
        float rs[8];
#pragma unroll
        for (int ai = 0; ai < 2; ++ai) {
            if (ssqp) { f32x4 pv[4][4];
#pragma unroll
                for (int m = 0; m < 4; ++m) { const f32x4* sp = (const f32x4*)(ssqp + (unsigned)(row0 + ai * 128 + m * 16) * 16u); pv[m][0] = sp[0]; pv[m][1] = sp[1]; pv[m][2] = sp[2]; pv[m][3] = sp[3]; }
#pragma unroll
                for (int m = 0; m < 4; ++m) { const f32x4 a = pv[m][0], b = pv[m][1], c = pv[m][2], d = pv[m][3];
                    const float sm = ((a[0] + a[1]) + (a[2] + a[3])) + ((b[0] + b[1]) + (b[2] + b[3])) + ((c[0] + c[1]) + (c[2] + c[3])) + ((d[0] + d[1]) + (d[2] + d[3]));
                    rs[ai * 4 + m] = __builtin_amdgcn_rsqf(sm * (1.f / 1024.f) + RMS_EPS); } }
            else {
#pragma unroll
                for (int m = 0; m < 4; ++m) rs[ai * 4 + m] = rstd[row0 + ai * 128 + m * 16]; }
            asm volatile("" ::: "memory"); }
        if (gw == 0) {
#pragma unroll
            for (int ai = 0; ai < 2; ++ai)
#pragma unroll
                for (int m = 0; m < 4; ++m) { bfr* rowp = Ob + (loff + (unsigned)(ai * 128 + m * 16) * (unsigned)NPROJ); const float r = rs[ai * 4 + m];
#pragma unroll
                    for (int bj = 0; bj < 2; ++bj) { const pg8::f32x4 v0 = acc[ai][bj][m][0] * r, v1 = acc[ai][bj][m][1] * r;
                        u32x4 w; w.x = cvtpk(v0[0], v0[1]); w.y = cvtpk(v0[2], v0[3]); w.z = cvtpk(v1[0], v1[1]); w.w = cvtpk(v1[2], v1[3]);
                        *(u32x4*)(rowp + bj * 128) = w; } }
            return;
        }
#pragma unroll
        for (int ai = 0; ai < 2; ++ai)
#pragma unroll
            for (int m = 0; m < 4; ++m) { const float r = rs[ai * 4 + m];
#pragma unroll
                for (int bj = 0; bj < 2; ++bj) { const pg8::f32x4 v0 = acc[ai][bj][m][0] * r, v1 = acc[ai][bj][m][1] * r;
                    float ss = (v0[0] * v0[0] + v0[1] * v0[1]) + (v0[2] * v0[2] + v0[3] * v0[3]) + (v1[0] * v1[0] + v1[1] * v1[1]) + (v1[2] * v1[2] + v1[3] * v1[3]);
                    ss += shx(ss, 16, ln); ss += shx(ss, 32, ln);
                    if (fq_ == 0) xch[(rl0 + ai * 128 + m * 16) * 8 + bj * 4 + wc] = ss; } }
        asm volatile("s_waitcnt lgkmcnt(0)" ::: "memory"); __builtin_amdgcn_s_barrier(); asm volatile("" ::: "memory");
        const int cig = (gw == 128) ? (wc * 32 + 8 * fq_) : ((wc & 1) * 32 + 8 * fq_);
        float gn[8];
        { const f32x4 ga = *(const f32x4*)(gain + cig), gb = *(const f32x4*)(gain + cig + 4); gn[0] = ga[0]; gn[1] = ga[1]; gn[2] = ga[2]; gn[3] = ga[3]; gn[4] = gb[0]; gn[5] = gb[1]; gn[6] = gb[2]; gn[7] = gb[3]; }
        const bool rope_w = rope_t && ((gw == 128) ? (wc == 0) : ((wc & 1) == 0));
        const bool rope_l = (gw == 128) ? true : (fq_ < 2);
        const bool isx2 = (gw == 128) ? (fq_ >= 2) : (fq_ == 1);
        const int pd = (gw == 128) ? 32 : 16;
        const float inv_gw = (gw == 128) ? (1.f / 128.f) : (1.f / 64.f);
#pragma unroll
        for (int ap = 0; ap < 4; ++ap) { const int ai = ap >> 1, mb = (ap & 1) * 2;
            float cs[2][8], sn[2][8];
            if (rope_w) {
#pragma unroll
                for (int mm = 0; mm < 2; ++mm) { const int m = mm; const float* tb = rope + (size_t)(u.pm * 256 + rl0 + ai * 128 + (mb + mm) * 16) * 32;
                    if (gw == 128) { const int ib = (fq_ & 1) * 8; const f32x4 c0 = *(const f32x4*)(tb + ib), c1 = *(const f32x4*)(tb + ib + 4), s0 = *(const f32x4*)(tb + 16 + ib), s1 = *(const f32x4*)(tb + 16 + ib + 4);
#pragma unroll
                        for (int j = 0; j < 4; ++j) { cs[m][j] = c0[j]; cs[m][4 + j] = c1[j]; sn[m][j] = s0[j]; sn[m][4 + j] = s1[j]; } }
                    else { const f32x4 c0 = *(const f32x4*)(tb), c1 = *(const f32x4*)(tb + 4), c2 = *(const f32x4*)(tb + 8), c3 = *(const f32x4*)(tb + 12);
                        const f32x4 s0 = *(const f32x4*)(tb + 16), s1 = *(const f32x4*)(tb + 20), s2 = *(const f32x4*)(tb + 24), s3 = *(const f32x4*)(tb + 28);
                        cs[m][0] = c0[0]; cs[m][1] = c0[2]; cs[m][2] = c1[0]; cs[m][3] = c1[2]; cs[m][4] = c2[0]; cs[m][5] = c2[2]; cs[m][6] = c3[0]; cs[m][7] = c3[2];
                        sn[m][0] = s0[0]; sn[m][1] = s0[2]; sn[m][2] = s1[0]; sn[m][3] = s1[2]; sn[m][4] = s2[0]; sn[m][5] = s2[2]; sn[m][6] = s3[0]; sn[m][7] = s3[2]; } } }
#pragma unroll
            for (int mm = 0; mm < 2; ++mm) { const int m = mb + mm; const int rl = rl0 + ai * 128 + m * 16; const float r = rs[ai * 4 + m];
#pragma unroll
                for (int bj = 0; bj < 2; ++bj) {
                    float sq;
                    if (gw == 128) { const f32x4 x = *(const f32x4*)(xch + rl * 8 + bj * 4); sq = (x[0] + x[1]) + (x[2] + x[3]); }
                    else { const float* xp = xch + rl * 8 + bj * 4 + (wc & 2); sq = xp[0] + xp[1]; }
                    const float f = r * __builtin_amdgcn_rsqf(sq * inv_gw + RMS_EPS);
                    float v[8];
#pragma unroll
                    for (int j = 0; j < 4; ++j) { v[j] = acc[ai][bj][m][0][j] * f * gn[j]; v[4 + j] = acc[ai][bj][m][1][j] * f * gn[4 + j]; }
                    if (rope_w) { float pr[8];
#pragma unroll
                        for (int j = 0; j < 8; ++j) pr[j] = shx(v[j], pd, ln);
                        if (rope_l) {
#pragma unroll
                            for (int j = 0; j < 8; ++j) v[j] = isx2 ? (v[j] * cs[mm][j] + pr[j] * sn[mm][j]) : (v[j] * cs[mm][j] - pr[j] * sn[mm][j]); } }
                    u32x4 w; w.x = cvtpk(v[0] * scale, v[1] * scale); w.y = cvtpk(v[2] * scale, v[3] * scale); w.z = cvtpk(v[4] * scale, v[5] * scale); w.w = cvtpk(v[6] * scale, v[7] * scale);
                    *(u32x4*)(Ob + (loff + (unsigned)(ai * 128 + m * 16) * (unsigned)NPROJ) + bj * 128) = w; } }
            asm volatile("" ::: "memory"); }
    }
};
template <bool BASE_BF16>
struct EpiRes {
    static constexpr bool PERM = true, AFTER_DRAIN = false;
    const float* basef; const bfr* baseh; bfr* hb;
    __device__ __forceinline__ void operator()(const pg8::f32x4 (&acc)[2][2][4][2], const pg8::Unit& u, int wr, int wc, int fr, int fq) const {
        int fr_ = fr, fq_ = fq; asm volatile("" : "+v"(fr_), "+v"(fq_));
        const size_t ub = (size_t)u.pm * 256 * DM + u.pn * 256; const float* bfb = basef + ub; const bfr* bhb = baseh + ub; bfr* hbb = hb + ub;
        const unsigned loff = (unsigned)(wr * 64 + fr_) * DM + (unsigned)(wc * 32 + 8 * fq_);
#pragma unroll
        for (int ai = 0; ai < 2; ++ai)
#pragma unroll
            for (int m = 0; m < 4; ++m) { const unsigned off = loff + (unsigned)(ai * 128 + m * 16) * DM;
#pragma unroll
                for (int bj = 0; bj < 2; ++bj) { const unsigned o2 = off + bj * 128; f32x4 b0, b1;
                    if (BASE_BF16) { const u32x4 bw = *(const u32x4*)(bhb + o2);
                        b0[0] = __uint_as_float(bw.x << 16); b0[1] = __uint_as_float(bw.x & 0xffff0000u); b0[2] = __uint_as_float(bw.y << 16); b0[3] = __uint_as_float(bw.y & 0xffff0000u);
                        b1[0] = __uint_as_float(bw.z << 16); b1[1] = __uint_as_float(bw.z & 0xffff0000u); b1[2] = __uint_as_float(bw.w << 16); b1[3] = __uint_as_float(bw.w & 0xffff0000u); }
                    else { b0 = *(const f32x4*)(bfb + o2); b1 = *(const f32x4*)(bfb + o2 + 4); }
                    const f32x4 v0 = b0 + acc[ai][bj][m][0], v1 = b1 + acc[ai][bj][m][1];
                    u32x4 w; w.x = cvtpk(v0[0], v0[1]); w.y = cvtpk(v0[2], v0[3]); w.z = cvtpk(v1[0], v1[1]); w.w = cvtpk(v1[2], v1[3]);
                    *(u32x4*)(hbb + o2) = w; }
                asm volatile("" ::: "memory"); }
    }
};
struct EpiT1 {
    static constexpr bool PERM = true, AFTER_DRAIN = false;
    bfr* t1;
    __device__ __forceinline__ void operator()(const pg8::f32x4 (&acc)[2][2][4][2], const pg8::Unit& u, int wr, int wc, int fr, int fq) const {
        int fr_ = fr, fq_ = fq; asm volatile("" : "+v"(fr_), "+v"(fq_));
        bfr* tb = t1 + (size_t)u.pm * 256 * DM + u.pn * 256; const unsigned loff = (unsigned)(wr * 64 + fr_) * DM + (unsigned)(wc * 32 + 8 * fq_);
#pragma unroll
        for (int ai = 0; ai < 2; ++ai)
#pragma unroll
            for (int m = 0; m < 4; ++m) { const unsigned off = loff + (unsigned)(ai * 128 + m * 16) * DM;
#pragma unroll
                for (int bj = 0; bj < 2; ++bj) { const pg8::f32x4 v0 = acc[ai][bj][m][0], v1 = acc[ai][bj][m][1];
                    u32x4 w; w.x = cvtpk(v0[0], v0[1]); w.y = cvtpk(v0[2], v0[3]); w.z = cvtpk(v1[0], v1[1]); w.w = cvtpk(v1[2], v1[3]);
                    *(u32x4*)(tb + off + bj * 128) = w; }
                asm volatile("" ::: "memory"); }
    }
};
struct EpiGate {
    static constexpr bool PERM = true, AFTER_DRAIN = false;
    const bfr* hin; const bfr* t1; bfr* hb2; float* ssqp; float* fout;
    __device__ __forceinline__ void operator()(const pg8::f32x4 (&acc)[2][2][4][2], const pg8::Unit& u, int wr, int wc, int fr, int fq) const {
        int fr_ = fr, fq_ = fq; asm volatile("" : "+v"(fr_), "+v"(fq_));
        const int row0 = u.pm * 256 + wr * 64 + fr_;
        const size_t ub = (size_t)u.pm * 256 * DM + u.pn * 256; const bfr* hbp = hin + ub; const bfr* t1b = t1 + ub; bfr* hb2b = hb2 ? hb2 + ub : nullptr; float* fo = fout ? fout + ub : nullptr;
        const unsigned loff = (unsigned)(wr * 64 + fr_) * DM + (unsigned)(wc * 32 + 8 * fq_);
#pragma unroll
        for (int ai = 0; ai < 2; ++ai)
#pragma unroll
            for (int m = 0; m < 4; ++m) { const int row = row0 + ai * 128 + m * 16; const unsigned off = loff + (unsigned)(ai * 128 + m * 16) * DM; float ss = 0.f;
#pragma unroll
                for (int bj = 0; bj < 2; ++bj) { const unsigned o2 = off + bj * 128;
                    const u32x4 bw = *(const u32x4*)(hbp + o2); const u32x4 tw = *(const u32x4*)(t1b + o2);
                    const float bb[8] = {__uint_as_float(bw.x << 16), __uint_as_float(bw.x & 0xffff0000u), __uint_as_float(bw.y << 16), __uint_as_float(bw.y & 0xffff0000u),
                                         __uint_as_float(bw.z << 16), __uint_as_float(bw.z & 0xffff0000u), __uint_as_float(bw.w << 16), __uint_as_float(bw.w & 0xffff0000u)};
                    const float tt[8] = {__uint_as_float(tw.x << 16), __uint_as_float(tw.x & 0xffff0000u), __uint_as_float(tw.y << 16), __uint_as_float(tw.y & 0xffff0000u),
                                         __uint_as_float(tw.z << 16), __uint_as_float(tw.z & 0xffff0000u), __uint_as_float(tw.w << 16), __uint_as_float(tw.w & 0xffff0000u)};
                    f32x4 v0, v1;
#pragma unroll
                    for (int i = 0; i < 4; ++i) { v0[i] = bb[i] + tt[i] * sigmoid_f(acc[ai][bj][m][0][i]); v1[i] = bb[4 + i] + tt[4 + i] * sigmoid_f(acc[ai][bj][m][1][i]); }
                    if (fout) { __builtin_nontemporal_store(v0, (f32x4*)(fo + o2)); __builtin_nontemporal_store(v1, (f32x4*)(fo + o2 + 4)); }
                    if (hb2) { u32x4 w; w.x = cvtpk(v0[0], v0[1]); w.y = cvtpk(v0[2], v0[3]); w.z = cvtpk(v1[0], v1[1]); w.w = cvtpk(v1[2], v1[3]); *(u32x4*)(hb2b + o2) = w; }
                    ss += (v0[0] * v0[0] + v0[1] * v0[1]) + (v0[2] * v0[2] + v0[3] * v0[3]) + (v1[0] * v1[0] + v1[1] * v1[1]) + (v1[2] * v1[2] + v1[3] * v1[3]); }
                if (ssqp) { const int ln_ = fq_ * 16 + fr_;
                    ss += __int_as_float(__builtin_amdgcn_ds_bpermute((ln_ ^ 16) << 2, __float_as_int(ss))); ss += __int_as_float(__builtin_amdgcn_ds_bpermute((ln_ ^ 32) << 2, __float_as_int(ss))); if (fq_ == 0) ssqp[(unsigned)row * 16u + (unsigned)(u.pn * 4 + wc)] = ss; }
                asm volatile("" ::: "memory"); }
    }
};

__device__ __forceinline__ void transpose_item(const float* W, int ldw, int csrc, int K, int ncols, const float* g, bfr* WT, int row_off, float* scr, int item, int lane) {
    const int nblk = ncols / 32, kb = item / nblk, nb = item % nblk, k0 = 64 * kb, n0 = 32 * nb;
#pragma unroll 8
    for (int i = 0; i < 32; ++i) { const int kk = 2 * i + (lane >> 5); float v = __builtin_nontemporal_load(W + (size_t)(k0 + kk) * ldw + csrc + n0 + (lane & 31)); if (g) v *= g[k0 + kk]; scr[kk * 33 + (lane & 31)] = v; }
    asm volatile("s_waitcnt lgkmcnt(0)" ::: "memory");
    const int c = lane & 7;
#pragma unroll
    for (int j = 0; j < 4; ++j) { const int n = (lane >> 3) + 8 * j; const float* s = scr + (8 * c) * 33 + n;
        u32x4 o; o.x = cvtpk(s[0 * 33], s[1 * 33]); o.y = cvtpk(s[2 * 33], s[3 * 33]); o.z = cvtpk(s[4 * 33], s[5 * 33]); o.w = cvtpk(s[6 * 33], s[7 * 33]);
        *(u32x4*)(WT + (size_t)(row_off + n0 + n) * K + k0 + 8 * c) = o; }
    asm volatile("s_waitcnt lgkmcnt(0)" ::: "memory");
}

__device__ __forceinline__ void phase_prologue(const Params& P, char* lds, int G, int blk) {
    unsigned char* ws = P.ws;
    int tid_l = threadIdx.x; asm volatile("" : "+v"(tid_l));
    const int tid = tid_l, lane = tid & 63, wave = tid >> 6;
    const int gw = blk * 8 + wave, NGW = G * 8;
    float* wfs = (float*)(lds + 98304);
    for (int k = tid; k < DM; k += 512) { const f32x4 w = *(const f32x4*)(P.w_in_even + (size_t)k * EVEN_IN + 3072); const float g = P.norm_g[k]; *(f32x4*)(wfs + 4 * k) = w * g; }
    __syncthreads();
    bfr* xb = (bfr*)(ws + WS_A); float* rstd0 = (float*)(ws + WS_RSTD0); float* lf = (float*)(ws + WS_LF);
    const float bf0 = P.b_forget[0], bf1 = P.b_forget[1], bf2 = P.b_forget[2], bf3 = P.b_forget[3];
    for (int m0 = gw; m0 < TOK; m0 += 2 * NGW) {
        f32x4 vv[2][4];
#pragma unroll
        for (int q = 0; q < 2; ++q) { const int m = m0 + q * NGW; if (m < TOK) { const f32x4* xr = (const f32x4*)(P.x + (size_t)m * DM) + lane;
#pragma unroll
            for (int j = 0; j < 4; ++j) vv[q][j] = __builtin_nontemporal_load(xr + 64 * j); } }
#pragma unroll
        for (int q = 0; q < 2; ++q) { const int m = m0 + q * NGW; if (m >= TOK) break;
        f32x4 v[4]; float ss = 0.f; f32x4 fa = {0.f, 0.f, 0.f, 0.f};
#pragma unroll
        for (int j = 0; j < 4; ++j) { v[j] = vv[q][j]; ss += (v[j][0] * v[j][0] + v[j][1] * v[j][1]) + (v[j][2] * v[j][2] + v[j][3] * v[j][3]);
#pragma unroll
            for (int i = 0; i < 4; ++i) { const f32x4 w = *(const f32x4*)(wfs + 4 * (256 * j + 4 * lane + i)); fa += w * v[j][i]; } }
        ss = wave_sum(ss, lane); const float rs = __builtin_amdgcn_rsqf(ss * (1.f / DM) + RMS_EPS);
        fa[0] = wave_sum(fa[0], lane); fa[1] = wave_sum(fa[1], lane); fa[2] = wave_sum(fa[2], lane); fa[3] = wave_sum(fa[3], lane);
        unsigned long long* o8 = (unsigned long long*)(xb + (size_t)m * DM) + lane;
#pragma unroll
        for (int j = 0; j < 4; ++j) o8[64 * j] = (unsigned long long)cvtpk(v[j][0], v[j][1]) | ((unsigned long long)cvtpk(v[j][2], v[j][3]) << 32);
        if (lane < 4) { const float y = (lane == 0 ? fa[0] : lane == 1 ? fa[1] : lane == 2 ? fa[2] : fa[3]) * rs + (lane == 0 ? bf0 : lane == 1 ? bf1 : lane == 2 ? bf2 : bf3);
            const float ls = fminf(y, 0.f) - log1pf(__expf(-fabsf(y)));
            const int b = m / SEQ, s = m % SEQ; lf[(size_t)(b * 4 + lane) * SEQ + s] = ls; }
        if (lane == 0) rstd0[m] = rs; }
    }
    { float* rope = (float*)(ws + WS_ROPE);
      for (int e = blk * 512 + tid; e < TOK * 16; e += G * 512) { const int t = e >> 4, i = e & 15;
          const float invf = expf(-13.122363377404328f * (float)i / 16.f), ang = (float)P.positions[t] * invf;
          const double rev = (double)ang * 0.15915494309189535; const float fr = (float)(rev - rint(rev));
          rope[t * 32 + i] = __builtin_amdgcn_cosf(fr); rope[t * 32 + 16 + i] = __builtin_amdgcn_sinf(fr); } }
    __syncthreads();
    float* scr = (float*)(lds + wave * 16384);
    constexpr int I0 = 16 * 96, I1 = 16 * 32, I2 = 512, I3 = 16 * 128, I4 = 512, I5 = 512, I6 = 512, I7 = 128, I8 = 128;
    for (int it = gw; it < I0 + I1; it += NGW) { int r = it;
        if (r < I0) { transpose_item(P.w_in_even, EVEN_IN, 0, DM, 3072, P.norm_g, (bfr*)(ws + WS_W0T), 0, scr, r, lane); continue; } r -= I0;
        transpose_item(P.w_in_even, EVEN_IN, 3076, DM, 1024, P.norm_g, (bfr*)(ws + WS_W0T), 3072, scr, r, lane);
    }
}
__device__ __forceinline__ void phase_late_weights(const Params& P, char* lds, int G, int blk) {
    unsigned char* ws = P.ws;
    int tid_l = threadIdx.x; asm volatile("" : "+v"(tid_l));
    const int tid = tid_l, lane = tid & 63, wave = tid >> 6;
    const int gw = blk * 8 + wave, NGW = G * 8;
    float* scr = (float*)(lds + wave * 16384);
    constexpr int I2 = 512, I3 = 16 * 128, I4 = 512, I5 = 512, I6 = 512, I7 = 128, I8 = 128;
    constexpr int NIT = I2 + I3 + I4 + I5 + I6 + I7 + I8;
    for (int it = gw; it < NIT; it += NGW) { int r = it;
        if (r < I2) { transpose_item(P.w_out_even, DM, 0, DM, DM, nullptr, (bfr*)(ws + WS_WO0T), 0, scr, r, lane); continue; } r -= I2;
        if (r < I3) { transpose_item(P.w_in_odd, NPROJ, 0, DM, NPROJ, P.norm_g + DM, (bfr*)(ws + WS_W1T), 0, scr, r, lane); continue; } r -= I3;
        if (r < I4) { transpose_item(P.w_out_odd, DM, 0, DM, DM, nullptr, (bfr*)(ws + WS_WO1T), 0, scr, r, lane); continue; } r -= I4;
        if (r < I5) { transpose_item(P.w_ple_gate, DM, 0, DM, DM, nullptr, (bfr*)(ws + WS_WG0T), 0, scr, r, lane); continue; } r -= I5;
        if (r < I6) { transpose_item(P.w_ple_gate + (size_t)DM * DM, DM, 0, DM, DM, nullptr, (bfr*)(ws + WS_WG1T), 0, scr, r, lane); continue; } r -= I6;
        if (r < I7) { transpose_item(P.w_ple, DM, 0, PLE, DM, nullptr, (bfr*)(ws + WS_WP0T), 0, scr, r, lane); continue; } r -= I7;
        transpose_item(P.w_ple + (size_t)PLE * DM, DM, 0, PLE, DM, nullptr, (bfr*)(ws + WS_WP1T), 0, scr, r, lane);
    }
    __syncthreads();
}
__device__ __forceinline__ void convert_p(const float* p, bfr* pb, int G, int blk) {
    const size_t n8 = (size_t)TOK * PLE / 8;
    int tid_l = threadIdx.x; asm volatile("" : "+v"(tid_l));
    const size_t stride = (size_t)G * 512;
    for (size_t i0 = (size_t)blk * 512 + tid_l; i0 < n8; i0 += 4 * stride) {
        f32x4 av[4], bv[4];
#pragma unroll
        for (int q = 0; q < 4; ++q) { const size_t i = i0 + q * stride; if (i < n8) { av[q] = __builtin_nontemporal_load((const f32x4*)(p + 8 * i)); bv[q] = __builtin_nontemporal_load((const f32x4*)(p + 8 * i + 4)); } }
#pragma unroll
        for (int q = 0; q < 4; ++q) { const size_t i = i0 + q * stride; if (i >= n8) break; const f32x4 a = av[q], b = bv[q];
        u32x4 w; w.x = cvtpk(a[0], a[1]); w.y = cvtpk(a[2], a[3]); w.z = cvtpk(b[0], b[1]); w.w = cvtpk(b[2], b[3]);
        *(u32x4*)(pb + 8 * i) = w; } }
}
__device__ __forceinline__ void cumsum_seq(const float* lf, float* c, char* lds) {
    int tid_l = threadIdx.x; asm volatile("" : "+v"(tid_l));
    const int tid = tid_l, lane = tid & 63, wave = tid >> 6;
    float* sh = (float*)lds;
    const f32x4 a = *(const f32x4*)(lf + tid * 8), b = *(const f32x4*)(lf + tid * 8 + 4);
    float v[8] = {a[0], a[1], a[2], a[3], b[0], b[1], b[2], b[3]};
#pragma unroll
    for (int i = 1; i < 8; ++i) v[i] += v[i - 1];
    float x = v[7];
#pragma unroll
    for (int o = 1; o < 64; o <<= 1) { const float t = __int_as_float(__builtin_amdgcn_ds_bpermute((lane - o) << 2, __float_as_int(x))); if (lane >= o) x += t; }
    if (lane == 63) sh[wave] = x;
    __syncthreads();
    float woff = 0.f;
    for (int w = 0; w < wave; ++w) woff += sh[w];
    const float ex = x - v[7] + woff;
    constexpr float L2E = 1.4426950408889634f;
    f32x4 oa = {(v[0] + ex) * L2E, (v[1] + ex) * L2E, (v[2] + ex) * L2E, (v[3] + ex) * L2E}, ob = {(v[4] + ex) * L2E, (v[5] + ex) * L2E, (v[6] + ex) * L2E, (v[7] + ex) * L2E};
    *(f32x4*)(c + tid * 8) = oa; *(f32x4*)(c + tid * 8 + 4) = ob;
    __syncthreads();
}
template <int LAYER>
__device__ __forceinline__ void nr_pass(const Params& P, bfr* proj, int G, int blk) {
    int tid_l = threadIdx.x; asm volatile("" : "+v"(tid_l));
    const int tid = tid_l, j = tid & 15, sg = (tid >> 4) & 15, rsel = tid >> 8, ln = tid & 63;
    int col, gw; const float* gain; float scale; bool rope;
    if (LAYER == 0) {
        if (sg < 4) { col = sg * 128; gw = 64; gain = P.qn_a; scale = 0.125f; rope = true; }
        else if (sg < 8) { col = 512 + (sg - 4) * 128; gw = 64; gain = P.kn_a; scale = 1.f; rope = true; }
        else if (sg < 12) { col = 1536 + (sg - 8) * 128; gw = 128; gain = P.qn_b; scale = 0.08838834764831845f; rope = false; }
        else { col = 2048 + (sg - 12) * 128; gw = 128; gain = P.kn_b; scale = 1.f; rope = false; }
    } else {
        if (sg < 8) { col = sg * 128; gw = 128; gain = P.qn_c; scale = 0.08838834764831845f; rope = true; }
        else { col = 1024 + (sg - 8) * 128; gw = 128; gain = P.kn_c; scale = 1.f; rope = true; }
    }
    const int jj = (gw == 128) ? j : (j & 7);
    float gn[8];
#pragma unroll
    for (int e = 0; e < 8; ++e) gn[e] = gain[jj * 8 + e];
    const int half = gw / 8, pd = (gw == 128) ? 2 : 1;
    const bool rl = rope && (jj < ((gw == 128) ? 4 : 2));
    const bool isx2 = (gw == 128) ? ((jj & 2) != 0) : ((jj & 1) != 0);
    const int ibase = (gw == 128) ? (jj & 1) * 8 : 0;
    float invf[8];
#pragma unroll
    for (int e = 0; e < 8; ++e) invf[e] = expf(-13.122363377404328f * (float)(ibase + e) / (float)half);
    for (int rp0 = blk; rp0 < TOK / 2; rp0 += 4 * G) {
        u32x4 rawv[4]; float posv[4];
#pragma unroll
        for (int q = 0; q < 4; ++q) { const int rp = rp0 + q * G; if (rp < TOK / 2) { const int row = rp * 2 + rsel;
            rawv[q] = *(const u32x4*)(proj + (size_t)row * NPROJ + col + j * 8); posv[q] = rl ? (float)P.positions[row] : 0.f; } }
#pragma unroll
        for (int q = 0; q < 4; ++q) { const int rp = rp0 + q * G; if (rp >= TOK / 2) break;
        const int row = rp * 2 + rsel;
        bfr* ptr = proj + (size_t)row * NPROJ + col + j * 8;
        const u32x4 raw = rawv[q];
        float f[8] = {__uint_as_float(raw.x << 16), __uint_as_float(raw.x & 0xffff0000u), __uint_as_float(raw.y << 16), __uint_as_float(raw.y & 0xffff0000u),
                      __uint_as_float(raw.z << 16), __uint_as_float(raw.z & 0xffff0000u), __uint_as_float(raw.w << 16), __uint_as_float(raw.w & 0xffff0000u)};
        float ss = 0.f;
#pragma unroll
        for (int e = 0; e < 8; ++e) ss += f[e] * f[e];
        ss += shx(ss, 1, ln); ss += shx(ss, 2, ln); ss += shx(ss, 4, ln);
        { const float t = shx(ss, 8, ln); if (gw == 128) ss += t; }
        const float rs = __builtin_amdgcn_rsqf(ss / (float)gw + RMS_EPS);
        float v[8], pr[8];
#pragma unroll
        for (int e = 0; e < 8; ++e) v[e] = f[e] * rs * gn[e];
#pragma unroll
        for (int e = 0; e < 8; ++e) pr[e] = shx(v[e], pd, ln);
        if (rl) { const float pos = posv[q];
#pragma unroll
            for (int e = 0; e < 8; ++e) { const float ang = pos * invf[e]; const double rev = (double)ang * 0.15915494309189535; const float fr = (float)(rev - rint(rev));
                const float sn = __builtin_amdgcn_sinf(fr), cs = __builtin_amdgcn_cosf(fr);
                v[e] = isx2 ? (v[e] * cs + pr[e] * sn) : (v[e] * cs - pr[e] * sn); } }
        u32x4 w; w.x = cvtpk(v[0] * scale, v[1] * scale); w.y = cvtpk(v[2] * scale, v[3] * scale); w.z = cvtpk(v[4] * scale, v[5] * scale); w.w = cvtpk(v[6] * scale, v[7] * scale);
        *(u32x4*)ptr = w; }
    }
}

__device__ __forceinline__ void store_pair_bf16(bfr* p, float v, int r32) { const float vn = __shfl_xor(v, 1); if ((r32 & 1) == 0) *(unsigned*)p = cvtpk(v, vn); }

__device__ __forceinline__ float bflo(unsigned w) { return __uint_as_float(w << 16); }
__device__ __forceinline__ float bfhi(unsigned w) { return __uint_as_float(w & 0xffff0000u); }
__device__ __forceinline__ void phase_attn0(const Params& P, char* lds, int G, int blk) {
    unsigned char* ws = P.ws;
    const bfr* proj = (const bfr*)(ws + WS_PROJ); bfr* mixed = (bfr*)(ws + WS_CC); float* o1s = (float*)(ws + WS_B); const float* cc = (const float*)(ws + WS_C);
    int tid_l = threadIdx.x; asm volatile("" : "+v"(tid_l));
    const int tid = tid_l, wid = __builtin_amdgcn_readfirstlane(tid >> 6), lane = tid & 63, r32 = lane & 31, hi = lane >> 5;
    float lam;
    { const float a = wave_sum(P.lam_q1[lane] * P.lam_k1[lane], lane), b = wave_sum(P.lam_q2[lane] * P.lam_k2[lane], lane); lam = expf(a) - expf(b) + LAM_INIT0; }
    const int vblk = (G % 8 == 0) ? (blk % 8) * (G / 8) + blk / 8 : blk;
    att::bf16x8 qr[8]; bool have_q = false;
    for (int w = vblk; w < 256; w += G) {
        const int bh = w >> 3, s = w & 7, b = bh >> 2, h = bh & 3;
        const size_t tok0 = (size_t)b * SEQ;
        for (int pass = 0; pass < 2; ++pass) {
            const int qb = pass == 0 ? 15 - s : s;
            att::f32x16 o[4]; float m_reg, l_reg;
            att::Unit U; U.stride = NPROJ; U.q0 = qb * 256; U.j_lo = 0; U.j_hi = (qb + 1) * 4; U.W = 1 << 29;
            U.Q = proj + tok0 * NPROJ + 1536 + h * 128; U.K = proj + tok0 * NPROJ + 2048 + h * 128; U.V = proj + tok0 * NPROJ + 2560 + h * 128; U.c = cc + (size_t)bh * SEQ;
            att::unit_core<128, true, false>(U, lds, o, m_reg, l_reg, qr, have_q, proj + tok0 * NPROJ + h * 128, NPROJ, U.q0, 4); have_q = true;
            { int ln_ = lane; asm volatile("" : "+v"(ln_)); const int row = ln_ >> 1, half = ln_ & 1;
              const float* stg = (const float*)(lds + wid * 16384);
              const size_t tk = tok0 + U.q0 + wid * 32 + row; const int c0 = 512 + h * 128 + half * 64;
              const u32x4* zp = (const u32x4*)(proj + tk * NPROJ + 3072 + c0); u32x4* mp = (u32x4*)(mixed + tk * DM + c0);
              u32x4 zq[8];
#pragma unroll
              for (int j = 0; j < 8; ++j) zq[j] = zp[(j + row) & 7];
#pragma unroll
              for (int j = 0; j < 8; ++j) { const int jp = (j + row) & 7; const f32x4 a = att::stg_chunk(stg, row, half, 2 * jp), c = att::stg_chunk(stg, row, half, 2 * jp + 1); const u32x4 z = zq[j]; u32x4 wv;
                  wv.x = cvtpk(a[0] * silu_f(bflo(z.x)), a[1] * silu_f(bfhi(z.x))); wv.y = cvtpk(a[2] * silu_f(bflo(z.y)), a[3] * silu_f(bfhi(z.y)));
                  wv.z = cvtpk(c[0] * silu_f(bflo(z.z)), c[1] * silu_f(bfhi(z.z))); wv.w = cvtpk(c[2] * silu_f(bflo(z.w)), c[3] * silu_f(bfhi(z.w)));
                  mp[jp] = wv; } }
            __syncthreads();
            U.V = proj + tok0 * NPROJ + 1024 + h * 128; U.c = nullptr;
            U.Q = proj + tok0 * NPROJ + h * 128; U.K = proj + tok0 * NPROJ + 512 + h * 128;
            att::unit_core<64, false, false>(U, lds, o, m_reg, l_reg, qr, true, U.Q + 64, NPROJ, U.q0, 4);
            { int ln_ = lane; asm volatile("" : "+v"(ln_)); const int row = ln_ >> 1, half = ln_ & 1;
              const float* stg = (const float*)(lds + wid * 16384);
              const size_t tk = tok0 + U.q0 + wid * 32 + row;
              f32x4* op = (f32x4*)(o1s + tk * 512 + h * 128 + half * 64);
#pragma unroll
              for (int j = 0; j < 16; ++j) { const int jp = (j + 2 * row) & 15; op[jp] = att::stg_chunk(stg, row, half, jp); } }
            __syncthreads();
            U.Q += 64; U.K += 64;
            {
              const bfr* nq = nullptr; int nq0 = 0, nfr = 0;
              if (pass == 0) { nq = proj + tok0 * NPROJ + 1536 + h * 128; nq0 = s * 256; nfr = 8; }
              else if (w + G < 256) { const int w2 = w + G, bh2 = w2 >> 3, s2 = w2 & 7; nq = proj + (size_t)(bh2 >> 2) * SEQ * NPROJ + 1536 + (bh2 & 3) * 128; nq0 = (15 - s2) * 256; nfr = 8; }
              att::unit_core<64, false, false>(U, lds, o, m_reg, l_reg, qr, true, nq, NPROJ, nq0, nfr); }
            { int ln_ = lane; asm volatile("" : "+v"(ln_)); const int row = ln_ >> 1, half = ln_ & 1;
              const float* stg = (const float*)(lds + wid * 16384);
              const size_t tk = tok0 + U.q0 + wid * 32 + row; const int c0 = h * 128 + half * 64;
              const f32x4* op = (const f32x4*)(o1s + tk * 512 + c0);
              const u32x4* zp = (const u32x4*)(proj + tk * NPROJ + 3072 + c0); u32x4* mp = (u32x4*)(mixed + tk * DM + c0);
              const f32x4* gp = (const f32x4*)(P.subln_g + half * 64);
              f32x4 v[16]; u32x4 zq[8]; float ss = 0.f;
#pragma unroll
              for (int j = 0; j < 16; ++j) v[j] = op[(j + 2 * row) & 15];
#pragma unroll
              for (int j = 0; j < 8; ++j) zq[j] = zp[(j + row) & 7];
#pragma unroll
              for (int j = 0; j < 16; ++j) { v[j] = v[j] - att::stg_chunk(stg, row, half, (j + 2 * row) & 15) * lam; ss += (v[j][0] * v[j][0] + v[j][1] * v[j][1]) + (v[j][2] * v[j][2] + v[j][3] * v[j][3]); }
              ss += __int_as_float(__builtin_amdgcn_ds_bpermute((ln_ ^ 1) << 2, __float_as_int(ss)));
              const float rs = __builtin_amdgcn_rsqf(ss * (1.f / 128.f) + RMS_EPS) * (1.f - LAM_INIT0);
#pragma unroll
              for (int j = 0; j < 8; ++j) { const int jp = (j + row) & 7; const f32x4 ga = gp[2 * jp], gb = gp[2 * jp + 1]; const f32x4 a = v[2 * j] * ga * rs, c = v[2 * j + 1] * gb * rs; const u32x4 z = zq[j]; u32x4 wv;
                  wv.x = cvtpk(a[0] * silu_f(bflo(z.x)), a[1] * silu_f(bfhi(z.x))); wv.y = cvtpk(a[2] * silu_f(bflo(z.y)), a[3] * silu_f(bfhi(z.y)));
                  wv.z = cvtpk(c[0] * silu_f(bflo(z.z)), c[1] * silu_f(bfhi(z.z))); wv.w = cvtpk(c[2] * silu_f(bflo(z.w)), c[3] * silu_f(bfhi(z.w)));
                  mp[jp] = wv; } }
            __syncthreads();
        }
    }
}
__device__ __forceinline__ void phase_attn1(const Params& P, char* lds, int G, int blk) {
    unsigned char* ws = P.ws;
    const bfr* proj = (const bfr*)(ws + WS_PROJ); float* lse = (float*)(ws + WS_LSE);
    int tid_l = threadIdx.x; asm volatile("" : "+v"(tid_l));
    const int tid = tid_l, wid = __builtin_amdgcn_readfirstlane(tid >> 6), lane = tid & 63, r32 = lane & 31, hi = lane >> 5;
    const int vblk = (G % 8 == 0) ? (blk % 8) * (G / 8) + blk / 8 : blk;
    att::bf16x8 qr[8]; bool have_q = false;
    for (int u = vblk; u < 3072; u += G) {
        const int bh = u / 48, rem = u % 48, pat = rem >> 4, idx = rem & 15, b = bh >> 3, h = bh & 7;
        const int dil = pat == 0 ? 1 : pat == 1 ? 4 : 16;
        const int res = idx % dil, qb = idx / dil;
        const size_t tok0 = (size_t)b * SEQ + res;
        const bfr* nq = nullptr; long nstr = 0; int nq0 = 0, nfr = 0;
        if (u + G < 3072) { const int u2 = u + G, bh2 = u2 / 48, rem2 = u2 % 48, pat2 = rem2 >> 4, idx2 = rem2 & 15; const int dil2 = pat2 == 0 ? 1 : pat2 == 1 ? 4 : 16;
            nq = proj + ((size_t)(bh2 >> 3) * SEQ + (idx2 % dil2)) * NPROJ + (bh2 & 7) * 128; nstr = (long)NPROJ * dil2; nq0 = (idx2 / dil2) * 256; nfr = 8; }
        bfr* part = pat == 2 ? (bfr*)P.out : (bfr*)(ws + WS_A + (size_t)pat * 64 * MiB);
        att::f32x16 o[4]; float m_reg, l_reg;
        att::Unit U; U.stride = (long)NPROJ * dil; U.q0 = qb * 256; U.j_lo = qb == 0 ? 0 : (qb * 256 - 128) / 64; U.j_hi = (qb + 1) * 4; U.W = 129; U.c = nullptr;
        U.Q = proj + tok0 * NPROJ + h * 128; U.K = proj + tok0 * NPROJ + 1024 + h * 128; U.V = proj + tok0 * NPROJ + 2048 + h * 128;
        att::unit_core<128, false, true>(U, lds, o, m_reg, l_reg, qr, have_q, nq, nstr, nq0, nfr); have_q = true;
        if (hi == 0) { const size_t tk = tok0 + (size_t)(U.q0 + wid * 32 + r32) * dil; lse[((size_t)pat * TOK + tk) * 8 + h] = m_reg * 0.6931471805599453f + __logf(l_reg); }
        {
          int ln_ = lane; asm volatile("" : "+v"(ln_)); const int ch = ln_ & 7, half = (ln_ >> 3) & 1, r4 = ln_ >> 4;
          const float* stg = (const float*)(lds + wid * 16384) + r4 * 128 + half * 64 + 8 * ch;
          bfr* pl = part + (tok0 + (size_t)(U.q0 + wid * 32 + r4) * dil) * DM + h * 128 + half * 64 + 8 * ch;
          const size_t jstep = (size_t)4 * dil * DM;
#pragma unroll
          for (int j = 0; j < 8; ++j) { const f32x4 a = *(const f32x4*)(stg + j * 4 * 128), c = *(const f32x4*)(stg + j * 4 * 128 + 4); u32x4 wv;
              wv.x = cvtpk(a[0], a[1]); wv.y = cvtpk(a[2], a[3]); wv.z = cvtpk(c[0], c[1]); wv.w = cvtpk(c[2], c[3]);
              __builtin_nontemporal_store(wv, (u32x4*)(pl + j * jstep)); } }
        __syncthreads();
    }
}
__device__ __forceinline__ void phase_merge1(const Params& P, int G, int blk) {
    unsigned char* ws = P.ws;
    const bfr* proj = (const bfr*)(ws + WS_PROJ); const float* lse = (const float*)(ws + WS_LSE);
    bfr* p0 = (bfr*)(ws + WS_A); const bfr* p1 = (const bfr*)(ws + WS_B); const bfr* p2 = (const bfr*)P.out;
    const size_t n8 = (size_t)TOK * DM / 8;
    int tid_l = threadIdx.x; asm volatile("" : "+v"(tid_l));
    const size_t stride = (size_t)G * 512;
    for (size_t i0 = (size_t)blk * 512 + tid_l; i0 < n8; i0 += 4 * stride) {
        u32x4 av[4], bv[4], cv[4], zv[4]; float lv[4][3];
#pragma unroll
        for (int q = 0; q < 4; ++q) { const size_t i = i0 + q * stride; if (i < n8) { const size_t tk = i >> 7; const int c = (int)(i & 127) * 8, h = c >> 7;
            lv[q][0] = lse[((size_t)0 * TOK + tk) * 8 + h]; lv[q][1] = lse[((size_t)1 * TOK + tk) * 8 + h]; lv[q][2] = lse[((size_t)2 * TOK + tk) * 8 + h];
            av[q] = __builtin_nontemporal_load((const u32x4*)(p0 + tk * DM + c)); bv[q] = __builtin_nontemporal_load((const u32x4*)(p1 + tk * DM + c)); cv[q] = __builtin_nontemporal_load((const u32x4*)(p2 + tk * DM + c)); zv[q] = __builtin_nontemporal_load((const u32x4*)(proj + tk * NPROJ + 3072 + c)); } }
#pragma unroll
        for (int q = 0; q < 4; ++q) { const size_t i = i0 + q * stride; if (i >= n8) break; const size_t tk = i >> 7; const int c = (int)(i & 127) * 8;
        const float l0 = lv[q][0], l1 = lv[q][1], l2 = lv[q][2];
        const float mx = fmaxf(l0, fmaxf(l1, l2)); float w0 = __expf(l0 - mx), w1 = __expf(l1 - mx), w2 = __expf(l2 - mx); const float inv = 1.f / (w0 + w1 + w2); w0 *= inv; w1 *= inv; w2 *= inv;
        const u32x4 a = av[q], bq = bv[q], cq = cv[q], zq = zv[q];
        u32x4 ow;
#pragma unroll
        for (int k = 0; k < 4; ++k) {
            const float alo = __uint_as_float(a[k] << 16), ahi = __uint_as_float(a[k] & 0xffff0000u), blo = __uint_as_float(bq[k] << 16), bhi = __uint_as_float(bq[k] & 0xffff0000u);
            const float clo = __uint_as_float(cq[k] << 16), chi = __uint_as_float(cq[k] & 0xffff0000u), zlo = __uint_as_float(zq[k] << 16), zhi = __uint_as_float(zq[k] & 0xffff0000u);
            ow[k] = cvtpk((w0 * alo + w1 * blo + w2 * clo) * silu_f(zlo), (w0 * ahi + w1 * bhi + w2 * chi) * silu_f(zhi)); }
        *(u32x4*)(p0 + tk * DM + c) = ow; } }
}

#define LAS __attribute__((address_space(3)))
#define XB_TMO      128
#define XB_XCNT(j)  (256  + 64 * (j))
#define XB_XSUB(j)  (1280 + 64 * (j))
#define XB_XGEN(j)  (2304 + 64 * (j))
#define XB_TOP      3328
#define XB_TOPGEN   3392
#define XCD_BAR_WORDS 3456
#define XB_SPIN_CAP (1u << 18)

__device__ __forceinline__ unsigned xb_ld(unsigned* p)              { return __hip_atomic_load(p, __ATOMIC_RELAXED, __HIP_MEMORY_SCOPE_AGENT); }
__device__ __forceinline__ unsigned xb_add(unsigned* p, unsigned v) { return __hip_atomic_fetch_add(p, v, __ATOMIC_RELAXED, __HIP_MEMORY_SCOPE_AGENT); }
__device__ __forceinline__ unsigned xb_xcc_id() { return (unsigned)__builtin_amdgcn_s_getreg((3 << 11) | 20) & 0xFu; }
#define XB_SPIN(cond, bar) do { unsigned _sp = 0; while (cond) { __builtin_amdgcn_s_sleep(1); \
    if ((++_sp & 255u) == 0u) { if (xb_ld(&(bar)[XB_TMO])) break; if (_sp > XB_SPIN_CAP) { atomicAdd(&(bar)[XB_TMO], 1u); break; } } } } while (0)

struct XcdBarrier {
    unsigned* bar; unsigned x;
    volatile LAS unsigned* st;
};

__device__ __forceinline__ XcdBarrier xcd_barrier_post(unsigned* bar, volatile LAS unsigned* st) {
    XcdBarrier b; b.bar = bar; b.x = xb_xcc_id(); b.st = st;
    if (threadIdx.x == 0) (void)xb_add(&bar[XB_XCNT(b.x)], 1u);
    return b;
}
__device__ __forceinline__ void xcd_barrier_complete(unsigned* bar, unsigned x, unsigned& nloc, unsigned& nx) {
    const unsigned G = gridDim.x * gridDim.y * gridDim.z;
    unsigned sum, cnt, mine, sp = 0u;
    for (;;) {
        sum = 0u; cnt = 0u; mine = 0u;
#pragma unroll
        for (unsigned j = 0; j < 16; ++j) { const unsigned c = xb_ld(&bar[XB_XCNT(j)]); sum += c; cnt += (c > 0u) ? 1u : 0u; mine = (j == x) ? c : mine; }
        if (sum == G) break;
        __builtin_amdgcn_s_sleep(1);
        if ((++sp & 255u) == 0u) { if (xb_ld(&bar[XB_TMO])) break; if (sp > XB_SPIN_CAP) { atomicAdd(&bar[XB_TMO], 1u); break; } }
    }
    nloc = mine > 0u ? mine : 1u; nx = cnt > 0u ? cnt : 1u;
}

__device__ __forceinline__ void xcd_barrier(const XcdBarrier& b) {
    asm volatile("s_waitcnt vmcnt(0)" ::: "memory");
    __syncthreads();
    if (threadIdx.x == 0) {
        unsigned* bar = b.bar;
        __builtin_amdgcn_s_waitcnt(0);
        unsigned nloc = b.st[0], nx = b.st[1];
        if (nloc == 0u) { xcd_barrier_complete(bar, b.x, nloc, nx); b.st[0] = nloc; b.st[1] = nx; }
        const unsigned old = xb_add(&bar[XB_XSUB(b.x)], 1u);
        const unsigned gen = old / nloc;
        if (old + 1u == (gen + 1u) * nloc) {
            __builtin_amdgcn_fence(__ATOMIC_RELEASE, "agent");
            asm volatile("s_waitcnt vmcnt(0)" ::: "memory");
            const unsigned og = xb_add(&bar[XB_TOP], 1u);
            const unsigned tg = og / nx;
            if (og + 1u == (tg + 1u) * nx) xb_add(&bar[XB_TOPGEN], 1u);
            else XB_SPIN(xb_ld(&bar[XB_TOPGEN]) == tg, bar);
            __builtin_amdgcn_fence(__ATOMIC_ACQUIRE, "agent");
            xb_add(&bar[XB_XGEN(b.x)], 1u);
            asm volatile("s_waitcnt vmcnt(0)" ::: "memory");
        } else {
            XB_SPIN(xb_ld(&bar[XB_XGEN(b.x)]) == gen, bar);
            __builtin_amdgcn_fence(__ATOMIC_ACQUIRE, "agent");
            asm volatile("s_waitcnt vmcnt(0)" ::: "memory");
        }
    }
    __syncthreads();
}

#ifndef PH
#define PH 4095
#endif
#ifndef DUP
#define DUP 0
#endif
__global__ void __launch_bounds__(512, 2) fwd_mega(Params P) {
    extern __shared__ __attribute__((aligned(16))) unsigned char lds_raw[];
    cg::grid_group grid = cg::this_grid();
    char* lds = (char*)lds_raw; PG8_LAS unsigned char* lds3 = (PG8_LAS unsigned char*)lds_raw;
    unsigned char* ws = P.ws; const int G = gridDim.x, blk = blockIdx.x;
    bfr* proj = (bfr*)(ws + WS_PROJ); bfr* bufA = (bfr*)(ws + WS_A); bfr* bufB = (bfr*)(ws + WS_B); bfr* bufC = (bfr*)(ws + WS_CC); bfr* pb = (bfr*)(ws + WS_PB);
    float* ssq = (float*)(ws + WS_SSQ);
    volatile LAS unsigned* bst = (volatile LAS unsigned*)(lds3 + 134144);
    if (threadIdx.x < 2) bst[threadIdx.x] = 0u;
    __syncthreads();
    XcdBarrier xbar = xcd_barrier_post((unsigned*)(ws + WS_BAR), bst);
    if (G == 0x7fffffff) grid.sync();
#if PH & 1
    phase_prologue(P, lds, G, blk);
#endif
#if DUP & 1
    grid.sync(); phase_prologue(P, lds, G, blk); convert_p(P.p, pb, G, blk);
#endif
#if DUP & 4096
    for (int i = 0; i < 10; ++i) xcd_barrier(xbar);
#endif
    xcd_barrier(xbar);
#if PH & 2
    { pg8::Gemm g{bufA, (const bfr*)(ws + WS_W0T), TOK, NPROJ, DM}; pg8::StaticOrder S; S.init(TOK, NPROJ, G, blk);
      for (int w = blk; w < 32; w += G) cumsum_seq((const float*)(ws + WS_LF) + (size_t)w * SEQ, (float*)(ws + WS_C) + (size_t)w * SEQ, lds);
      EpiProjNR<0> E{proj, (const float*)(ws + WS_RSTD0), nullptr, (const float*)(ws + WS_ROPE), P.qn_a, P.kn_a, P.qn_b, P.kn_b, (float*)(lds + LDS_XCH)};
      pg8::gemm_phase<EpiProjNR<0>, pg8::StaticOrder, true, true>(lds3, g, S, E);
    }
#endif
    xcd_barrier(xbar);
#if PH & 8
    phase_late_weights(P, lds, G, blk); convert_p(P.p, pb, G, blk);
    phase_attn0(P, lds, G, blk);
#endif
#if DUP & 8
    xcd_barrier(xbar); phase_attn0(P, lds, G, blk);
#endif
    xcd_barrier(xbar);
#if PH & 16
    { pg8::Gemm g{bufC, (const bfr*)(ws + WS_WO0T), TOK, DM, DM}; pg8::StaticOrder S; S.init(TOK, DM, G, blk);
      EpiRes<false> E{P.x, nullptr, bufA};
      pg8::gemm_phase<EpiRes<false>, pg8::StaticOrder, true, true>(lds3, g, S, E);
    }
#endif
    xcd_barrier(xbar);
#if PH & 32
    { pg8::Gemm g{pb, (const bfr*)(ws + WS_WP0T), TOK, DM, PLE}; pg8::StaticOrder S; S.init(TOK, DM, G, blk);
      EpiT1 E{bufB};
      pg8::gemm_phase<EpiT1, pg8::StaticOrder, true, true>(lds3, g, S, E);
#if DUP & 32
      xcd_barrier(xbar); pg8::gemm_phase<EpiT1, pg8::StaticOrder, true, true>(lds3, g, S, E);
#endif
    }
    { pg8::Gemm g{bufA, (const bfr*)(ws + WS_WG0T), TOK, DM, DM}; pg8::StaticOrder S; S.init(TOK, DM, G, blk);
      EpiGate E{bufA, bufB, bufC, ssq, nullptr};
      pg8::gemm_phase<EpiGate, pg8::StaticOrder, true, true>(lds3, g, S, E); }
#endif
    xcd_barrier(xbar);
#if PH & 64
    { pg8::Gemm g{bufC, (const bfr*)(ws + WS_W1T), TOK, NPROJ, DM}; pg8::StaticOrder S; S.init(TOK, NPROJ, G, blk);
      EpiProjNR<1> E{proj, nullptr, ssq, (const float*)(ws + WS_ROPE), nullptr, nullptr, P.qn_c, P.kn_c, (float*)(lds + LDS_XCH)};
      pg8::gemm_phase<EpiProjNR<1>, pg8::StaticOrder, true, true>(lds3, g, S, E); }
#endif
    xcd_barrier(xbar);
#if PH & 256
    phase_attn1(P, lds, G, blk);
#endif
#if DUP & 256
    xcd_barrier(xbar); phase_attn1(P, lds, G, blk);
#endif
    xcd_barrier(xbar);
#if PH & 512
    phase_merge1(P, G, blk); convert_p(P.p + (size_t)TOK * PLE, pb, G, blk);
#endif
    xcd_barrier(xbar);
#if PH & 1024
    { pg8::Gemm g{bufA, (const bfr*)(ws + WS_WO1T), TOK, DM, DM}; pg8::StaticOrder S; S.init(TOK, DM, G, blk);
      EpiRes<true> E{nullptr, bufC, bufB};
      pg8::gemm_phase<EpiRes<true>, pg8::StaticOrder, true, true>(lds3, g, S, E); }
#endif
    xcd_barrier(xbar);
#if PH & 2048
    { pg8::Gemm g{pb, (const bfr*)(ws + WS_WP1T), TOK, DM, PLE}; pg8::StaticOrder S; S.init(TOK, DM, G, blk);
      EpiT1 E{bufA};
      pg8::gemm_phase<EpiT1, pg8::StaticOrder, true, true>(lds3, g, S, E); }
    { pg8::Gemm g{bufB, (const bfr*)(ws + WS_WG1T), TOK, DM, DM}; pg8::StaticOrder S; S.init(TOK, DM, G, blk);
      EpiGate E{bufB, bufA, nullptr, nullptr, P.out};
      pg8::gemm_phase<EpiGate, pg8::StaticOrder, true, true>(lds3, g, S, E); }
#endif
}

extern "C" void kernel_launch(void* const* d_in, const int* in_sizes, int n_in, void* d_out, int out_size, void* d_ws, size_t ws_size, hipStream_t stream) {
    static int grid = 0;
    if (!grid) {
        if (n_in != 22 || out_size != TOK * DM || ws_size < WS_END) { fprintf(stderr, "kernel_launch: unexpected shapes (n_in %d out %d ws %zu)\n", n_in, out_size, ws_size); grid = -1; return; }
        int dev = 0, cus = 0, per_cu = 0;
        (void)hipGetDevice(&dev); (void)hipDeviceGetAttribute(&cus, hipDeviceAttributeMultiprocessorCount, dev);
        (void)hipFuncSetAttribute((const void*)fwd_mega, hipFuncAttributeMaxDynamicSharedMemorySize, LDS_BYTES);
        (void)hipOccupancyMaxActiveBlocksPerMultiprocessor(&per_cu, (const void*)fwd_mega, 512, LDS_BYTES);
        if (per_cu < 1) per_cu = 1;
        grid = cus * per_cu;
        fprintf(stderr, "grid %d (cus %d per_cu %d) ws %zu\n", grid, cus, per_cu, ws_size);
    }
    if (grid < 0) return;
    Params p{};
    p.x = (const float*)d_in[0]; p.p = (const float*)d_in[1]; p.positions = (const int*)d_in[2]; p.norm_g = (const float*)d_in[3]; p.w_in_even = (const float*)d_in[4];
    p.b_forget = (const float*)d_in[5]; p.qn_a = (const float*)d_in[6]; p.kn_a = (const float*)d_in[7]; p.qn_b = (const float*)d_in[8]; p.kn_b = (const float*)d_in[9];
    p.lam_q1 = (const float*)d_in[10]; p.lam_k1 = (const float*)d_in[11]; p.lam_q2 = (const float*)d_in[12]; p.lam_k2 = (const float*)d_in[13]; p.subln_g = (const float*)d_in[14];
    p.w_out_even = (const float*)d_in[15]; p.w_in_odd = (const float*)d_in[16]; p.qn_c = (const float*)d_in[17]; p.kn_c = (const float*)d_in[18]; p.w_out_odd = (const float*)d_in[19];
    p.w_ple = (const float*)d_in[20]; p.w_ple_gate = (const float*)d_in[21]; p.out = (float*)d_out; p.ws = (unsigned char*)d_ws;
    (void)hipMemsetAsync((char*)d_ws + WS_BAR, 0, BAR_BYTES, stream);
    void* args[] = {&p};
    hipError_t e = hipLaunchCooperativeKernel((const void*)fwd_mega, dim3(grid), dim3(512), args, LDS_BYTES, stream);
    if (e != hipSuccess) fprintf(stderr, "cooperative launch failed: %s (grid %d)\n", hipGetErrorString(e), grid);
}
```

```cpp
#include <hip/hip_runtime.h>
#include <hip/hip_bf16.h>
#include <hip/hip_cooperative_groups.h>
#include <cstdio>
#include <cstdint>
#include <cmath>
namespace cg = cooperative_groups;
namespace pg8 {
#define PG8_LAS __attribute__((address_space(3)))
typedef unsigned short bf16_t;
typedef short bf16x8 __attribute__((ext_vector_type(8)));
typedef float f32x4 __attribute__((ext_vector_type(4)));
typedef unsigned u32x4 __attribute__((ext_vector_type(4)));
constexpr int BM = 256, BK = 64, HALF = 128, HTB = HALF * BK * 2  , STAGE_BYTES = 8 * HTB, NXCD = 8, WGM = 8;

__host__ __device__ __forceinline__ int lds_byte(int r, int c) { const int st = (r >> 4) * 2 + (c >> 5), rr = r & 15, cc = c & 31, ob = rr * 64 + cc * 2; return st * 1024 + (ob ^ (((ob >> 9) & 1) << 5)); }
__host__ __device__ __forceinline__ void stage_rc(int b, int& R, int& C) { const int st = b / 1024, sb = b % 1024, swz = sb ^ (((sb >> 9) & 1) << 5); R = (st >> 1) * 16 + swz / 64; C = (st & 1) * 32 + (swz % 64) / 2; }
__host__ __device__ __forceinline__ int perm32(int rho) { const int n = rho >> 4, i = rho & 15; return 8 * (i >> 2) + 4 * n + (i & 3); }

struct Unit { int pm, pn; };
struct Gemm { const bf16_t* A; const bf16_t* Bt; int M, N, K; };

struct StaticOrder {
    int nM, nN, nwg, G, c;
    __host__ __device__ void init(int M, int N, int G_, int c_) { nM = M / BM; nN = N / BM; nwg = nM * nN; G = G_; c = c_; }
    __host__ __device__ bool next(int i, Unit& u) const {
        const long L = (long)i * G + c; if (L >= nwg) return false;
        int wgid = (int)L; { const int q = nwg / NXCD, r = nwg % NXCD, xcd = wgid % NXCD, off = wgid / NXCD; wgid = (xcd < r ? xcd * (q + 1) : r * (q + 1) + (xcd - r) * q) + off; }
        const int nig = WGM * nN, gid = wgid / nig, fm = gid * WGM, gsz = (nM - fm) < WGM ? (nM - fm) : WGM;
        u.pm = fm + ((wgid % nig) % gsz); u.pn = (wgid % nig) / gsz; return true;
    }
    __device__ __forceinline__ void a_ready(const Unit&) const {}
    __device__ __forceinline__ void done(const Unit&) const {}
};

__device__ __forceinline__ unsigned cvt_pk_bf16(float lo, float hi) { unsigned r; asm volatile("v_cvt_pk_bf16_f32 %0, %1, %2" : "=v"(r) : "v"(lo), "v"(hi)); return r; }
typedef float f32x2 __attribute__((ext_vector_type(2)));
__device__ __forceinline__ f32x2 gelu_pk(f32x2 v) {
    const f32x2 av = __builtin_elementwise_abs(v), d = av * 0.2316418882f + 1.0f;
    f32x2 t; t.x = __builtin_amdgcn_rcpf(d.x); t.y = __builtin_amdgcn_rcpf(d.y);
    f32x2 q = t * 0.5307027145f + (-0.7265760135f); q = q * t + 0.7107068705f; q = q * t + (-0.142248368f); q = q * t + 0.127414796f; q = q * t;
    const f32x2 s = (v * v) * (-0.72134752044f);
    f32x2 e; e.x = __builtin_amdgcn_exp2f(s.x); e.y = __builtin_amdgcn_exp2f(s.y);
    const f32x2 m = v * (q * e), r = v - m;
    f32x2 o; o.x = v.x < 0.f ? m.x : r.x; o.y = v.y < 0.f ? m.y : r.y; return o;
}

template <int ACT  > struct EpiBf16 {
    static constexpr bool PERM = true, AFTER_DRAIN = false; static_assert(ACT == 0 || ACT == 1, "EpiBf16: ACT is 0 (none) or 1 (gelu_pk)");
    bf16_t* O; int ldc; const float* bias; int split_cols; size_t split_stride; float scale0;
    __device__ __forceinline__ void operator()(const f32x4 (&acc)[2][2][4][2], const Unit& u, int wr, int wc, int fr, int fq) const {
        const int row0 = u.pm * BM + wr * 64 + fr; int colt = u.pn * BM; bf16_t* base = O;
        float sc = 1.f; if (split_cols) { const int t = colt / split_cols; base += (size_t)t * split_stride; colt -= t * split_cols; if (t == 0) sc = scale0; }
        const int col0 = colt + wc * 32 + 8 * fq, bcol0 = u.pn * BM + wc * 32 + 8 * fq;
        f32x4 bv[2][2];
#pragma unroll
        for (int bj = 0; bj < 2; ++bj)
#pragma unroll
            for (int n = 0; n < 2; ++n) bv[bj][n] = bias ? *(const f32x4*)(bias + bcol0 + bj * HALF + 4 * n) : (f32x4){0.f, 0.f, 0.f, 0.f};
#pragma unroll
        for (int ai = 0; ai < 2; ++ai)
#pragma unroll
            for (int m = 0; m < 4; ++m) { bf16_t* rowp = base + (size_t)(row0 + ai * HALF + m * 16) * ldc + col0;
#pragma unroll
                for (int bj = 0; bj < 2; ++bj) { f32x4 v0 = acc[ai][bj][m][0] + bv[bj][0], v1 = acc[ai][bj][m][1] + bv[bj][1];
                    if (ACT == 1) { f32x2 a = gelu_pk((f32x2){v0[0], v0[1]}), b = gelu_pk((f32x2){v0[2], v0[3]}), c = gelu_pk((f32x2){v1[0], v1[1]}), d = gelu_pk((f32x2){v1[2], v1[3]});
                        v0 = (f32x4){a.x, a.y, b.x, b.y}; v1 = (f32x4){c.x, c.y, d.x, d.y}; }
                    v0 = v0 * sc; v1 = v1 * sc; u32x4 w; w.x = cvt_pk_bf16(v0[0], v0[1]); w.y = cvt_pk_bf16(v0[2], v0[3]); w.z = cvt_pk_bf16(v1[0], v1[1]); w.w = cvt_pk_bf16(v1[2], v1[3]);
                    *(u32x4*)(rowp + bj * HALF) = w; } }
    }
};
template <class Epi, class Sched, bool ALIGN_EPI = false, bool SP2 = false>
__device__ __forceinline__ void gemm_phase(PG8_LAS unsigned char* lds, const Gemm g, const Sched& S, const Epi& E) {
    int tid_l = threadIdx.x; asm volatile("" : "+v"(tid_l));
    const int tid = tid_l, wid = __builtin_amdgcn_readfirstlane(tid >> 6), lane = tid & 63, wr = wid >> 2, wc = wid & 3, fr = lane & 15, fq = lane >> 4;
    int K_l = g.K; asm volatile("" : "+s"(K_l));
    const int K = K_l, nt = K / BK;
    unsigned voffA[2], voffB[2];
#pragma unroll
    for (int i = 0; i < 2; ++i) { int R, C; stage_rc(tid * 16 + i * 8192, R, C); const int Rb = Epi::PERM ? ((R & ~31) + perm32(R & 31)) : R;
        voffA[i] = (unsigned)(R * K + C) * 2u; voffB[i] = (unsigned)(Rb * K + C) * 2u; }
    const size_t kstep = (size_t)(BK * 2);
    const size_t hstep = (size_t)HALF * K * 2;
    const size_t tstep = 2 * hstep;
    const unsigned ldsw = (unsigned)wid * 1024u;
    const int aoff = lds_byte(wr * 64 + fr, fq * 8), boff = lds_byte(wc * 32 + fr, fq * 8);
#define PG8_SA(b, h) (((b) * 2 + (h)) * HTB)
#define PG8_SB(b, h) ((4 + (b) * 2 + (h)) * HTB)
#define PG8_STAGE(bufoff, gbase, voff) do { _Pragma("unroll") for (int _i = 0; _i < 2; ++_i) \
        __builtin_amdgcn_global_load_lds((const unsigned*)((const char*)(gbase) + (voff)[_i]), (PG8_LAS unsigned*)(lds + (bufoff) + ldsw + _i * 8192), 16, 0, 0); } while (0)
#define PG8_LDA(dst, b, h) do { _Pragma("unroll") for (int m = 0; m < 4; ++m) _Pragma("unroll") for (int k = 0; k < 2; ++k) dst[m][k] = *(const PG8_LAS bf16x8*)(lds + PG8_SA(b, h) + aoff + m * 2048 + k * 1024); } while (0)
#define PG8_LDB(dst, b, h) do { _Pragma("unroll") for (int n = 0; n < 2; ++n) _Pragma("unroll") for (int k = 0; k < 2; ++k) dst[n][k] = *(const PG8_LAS bf16x8*)(lds + PG8_SB(b, h) + boff + n * 2048 + k * 1024); } while (0)
#define PG8_MMA(ai, bj, At, Bt) do { __builtin_amdgcn_s_setprio(1); _Pragma("unroll") for (int m = 0; m < 4; ++m) _Pragma("unroll") for (int n = 0; n < 2; ++n) _Pragma("unroll") for (int k = 0; k < 2; ++k) \
        acc[ai][bj][m][n] = __builtin_amdgcn_mfma_f32_16x16x32_bf16(Bt[n][k], At[m][k], acc[ai][bj][m][n], 0, 0, 0); __builtin_amdgcn_s_setprio(0); } while (0)
#define PG8_WAIT_V(n) asm volatile("s_waitcnt vmcnt(" #n ")" ::: "memory")
#define PG8_WAIT_L(n) asm volatile("s_waitcnt lgkmcnt(" #n ")" ::: "memory")
#define PG8_BAR __builtin_amdgcn_s_barrier()
#define PG8_SCHED __builtin_amdgcn_sched_barrier(0)
    Unit cur, nxt; int ui = 0;
    if (!S.next(0, cur)) return;
    f32x4 acc[2][2][4][2];
#pragma unroll
    for (int a = 0; a < 2; ++a)
#pragma unroll
        for (int b = 0; b < 2; ++b)
#pragma unroll
            for (int m = 0; m < 4; ++m)
#pragma unroll
                for (int n = 0; n < 2; ++n) acc[a][b][m][n] = (f32x4){0.f, 0.f, 0.f, 0.f};
    bf16x8 At[4][2], B0[2][2], B1[2][2];
    const char* cA = (const char*)g.A + (size_t)cur.pm * tstep; const char* cB = (const char*)g.Bt + (size_t)cur.pn * tstep;
    S.a_ready(cur);
    if constexpr (SP2) {
        PG8_STAGE(PG8_SB(0, 0), cB, voffB); PG8_STAGE(PG8_SB(0, 1), cB + hstep, voffB); PG8_STAGE(PG8_SA(0, 0), cA, voffA); PG8_STAGE(PG8_SA(0, 1), cA + hstep, voffA);
        if (wr == 1) PG8_BAR;
        PG8_WAIT_V(2); PG8_BAR;
        PG8_STAGE(PG8_SB(1, 0), cB + kstep, voffB); PG8_STAGE(PG8_SA(1, 0), cA + kstep, voffA); PG8_STAGE(PG8_SB(1, 1), cB + hstep + kstep, voffB);
        PG8_WAIT_V(6); PG8_BAR;
    } else {
        PG8_STAGE(PG8_SB(0, 0), cB, voffB); PG8_STAGE(PG8_SA(0, 0), cA, voffA); PG8_STAGE(PG8_SB(0, 1), cB + hstep, voffB); PG8_STAGE(PG8_SA(0, 1), cA + hstep, voffA);
        if (wr == 1) PG8_BAR;
        PG8_WAIT_V(4); PG8_BAR;
        PG8_STAGE(PG8_SB(1, 0), cB + kstep, voffB); PG8_STAGE(PG8_SA(1, 0), cA + kstep, voffA); PG8_STAGE(PG8_SB(1, 1), cB + hstep + kstep, voffB);
        PG8_WAIT_V(6); PG8_BAR;
    }
    for (;;) {
        const bool has_next = S.next(ui + 1, nxt);
        const char* nA = has_next ? (const char*)g.A + (size_t)nxt.pm * tstep : cA; const char* nB = has_next ? (const char*)g.Bt + (size_t)nxt.pn * tstep : cB;
#pragma unroll 1
        for (int t = 0; t < nt; t += 2) {
            const bool last = (t == nt - 2);
            const char* a1 = cA + (size_t)(t + 1) * kstep;
            const char* a2 = last ? nA : cA + (size_t)(t + 2) * kstep; const char* b2 = last ? nB : cB + (size_t)(t + 2) * kstep;
            const char* a3 = a2 + kstep; const char* b3 = b2 + kstep;
            if (last && has_next) S.a_ready(nxt);
            if constexpr (SP2) {
            PG8_LDB(B0, 0, 0); PG8_LDB(B1, 0, 1); PG8_SCHED; PG8_LDA(At, 0, 0); PG8_STAGE(PG8_SA(1, 1), a1 + hstep, voffA);
            PG8_WAIT_V(8); PG8_WAIT_L(0); PG8_BAR; PG8_MMA(0, 0, At, B0); PG8_MMA(0, 1, At, B1); PG8_BAR; PG8_SCHED;
            PG8_LDA(At, 0, 1); PG8_STAGE(PG8_SB(0, 0), b2, voffB); PG8_STAGE(PG8_SB(0, 1), b2 + hstep, voffB); PG8_STAGE(PG8_SA(0, 0), a2, voffA);
            PG8_WAIT_V(8); PG8_WAIT_L(0); PG8_BAR; PG8_MMA(1, 0, At, B0); PG8_MMA(1, 1, At, B1); PG8_BAR; PG8_SCHED;
            PG8_LDB(B0, 1, 0); PG8_LDB(B1, 1, 1); PG8_SCHED; PG8_LDA(At, 1, 0); PG8_STAGE(PG8_SA(0, 1), a2 + hstep, voffA);
            PG8_WAIT_V(8); PG8_WAIT_L(0); PG8_BAR; PG8_MMA(0, 0, At, B0); PG8_MMA(0, 1, At, B1); PG8_BAR; PG8_SCHED;
            PG8_LDA(At, 1, 1); PG8_STAGE(PG8_SB(1, 0), b3, voffB); PG8_STAGE(PG8_SB(1, 1), b3 + hstep, voffB); PG8_STAGE(PG8_SA(1, 0), a3, voffA);
            PG8_WAIT_V(8); PG8_WAIT_L(0); PG8_BAR; PG8_MMA(1, 0, At, B0); PG8_MMA(1, 1, At, B1); PG8_BAR; PG8_SCHED;
            } else {
            PG8_LDB(B0, 0, 0); PG8_SCHED; PG8_LDA(At, 0, 0); PG8_STAGE(PG8_SA(1, 1), a1 + hstep, voffA);
            PG8_WAIT_L(8); PG8_BAR; PG8_WAIT_L(0); PG8_MMA(0, 0, At, B0); PG8_BAR; PG8_SCHED;
            PG8_LDB(B1, 0, 1); PG8_STAGE(PG8_SB(0, 0), b2, voffB);
            PG8_BAR; PG8_WAIT_L(0); PG8_MMA(0, 1, At, B1); PG8_BAR;
            PG8_LDA(At, 0, 1); PG8_STAGE(PG8_SA(0, 0), a2, voffA);
            PG8_BAR; PG8_WAIT_L(0); PG8_MMA(1, 0, At, B0); PG8_BAR; PG8_SCHED;
            PG8_STAGE(PG8_SB(0, 1), b2 + hstep, voffB);
            PG8_WAIT_V(6); PG8_BAR; PG8_MMA(1, 1, At, B1); PG8_BAR;
            PG8_LDB(B0, 1, 0); PG8_SCHED; PG8_LDA(At, 1, 0); PG8_STAGE(PG8_SA(0, 1), a2 + hstep, voffA);
            PG8_WAIT_L(8); PG8_BAR; PG8_WAIT_L(0); PG8_MMA(0, 0, At, B0); PG8_BAR; PG8_SCHED;
            PG8_LDB(B1, 1, 1); PG8_STAGE(PG8_SB(1, 0), b3, voffB);
            PG8_BAR; PG8_WAIT_L(0); PG8_MMA(0, 1, At, B1); PG8_BAR;
            PG8_LDA(At, 1, 1); PG8_STAGE(PG8_SA(1, 0), a3, voffA);
            PG8_BAR; PG8_WAIT_L(0); PG8_MMA(1, 0, At, B0); PG8_BAR; PG8_SCHED;
            PG8_STAGE(PG8_SB(1, 1), b3 + hstep, voffB);
            PG8_WAIT_V(6); PG8_BAR; PG8_MMA(1, 1, At, B1); PG8_BAR;
            }
        }
        if constexpr (ALIGN_EPI) { if (wr == 0) PG8_BAR; }
        if constexpr (!Epi::AFTER_DRAIN) { E(acc, cur, wr, wc, fr, fq); S.done(cur); }
        if (!has_next) break;
#pragma unroll
        for (int a = 0; a < 2; ++a)
#pragma unroll
            for (int b = 0; b < 2; ++b)
#pragma unroll
                for (int m = 0; m < 4; ++m)
#pragma unroll
                    for (int n = 0; n < 2; ++n) acc[a][b][m][n] = (f32x4){0.f, 0.f, 0.f, 0.f};
        cur = nxt; cA = nA; cB = nB; ++ui;
        if constexpr (ALIGN_EPI) { if (wr == 1) PG8_BAR; }
    }
    PG8_WAIT_V(0);
    if constexpr (!ALIGN_EPI) { if (wr == 0) PG8_BAR; }
    PG8_BAR;
    if constexpr (Epi::AFTER_DRAIN) { E.fused(acc, cur, wr, wc, fr, fq, lds, wid, lane); S.done(cur); }
#undef PG8_SA
#undef PG8_SB
#undef PG8_STAGE
#undef PG8_LDA
#undef PG8_LDB
#undef PG8_MMA
#undef PG8_WAIT_V
#undef PG8_WAIT_L
#undef PG8_BAR
#undef PG8_SCHED
}
}
namespace att {
constexpr float SCALE = 0.6931471805599453f;
constexpr float THR = 8.f;
constexpr int SHM_V = 16384, SHM_K = 16384;
using bf16 = __hip_bfloat16;
typedef short bf16x8 __attribute__((ext_vector_type(8)));
typedef short s16x4 __attribute__((ext_vector_type(4)));
typedef float f32x16 __attribute__((ext_vector_type(16)));
typedef float f32x4 __attribute__((ext_vector_type(4)));
typedef unsigned u32x4 __attribute__((ext_vector_type(4)));
template <class A, class Bt> struct same_t { static constexpr bool v = false; };
template <class A> struct same_t<A, A> { static constexpr bool v = true; };

#define KSWZ(row, colB) ((row) * 256 + ((colB) ^ (((row) & 7) << 4)))
#define SBAR() __builtin_amdgcn_sched_barrier(0)
__device__ __forceinline__ int v_st(int k, int c) { const int kk = (k & ~0xC) | ((k & 4) << 1) | ((k & 8) >> 1); return ((kk >> 3) * 4 + (c >> 5)) * 512 + ((kk & 7) * 32 + (c & 31)) * 2; }
__device__ __forceinline__ int v_rd_base(int lane) { return ((lane & 3) << 3) | (((lane >> 2) & 3) << 6) | (((lane >> 4) & 1) << 5) | (((lane >> 5) & 1) << 8); }
constexpr int v_rd_off(int d0, int ks, int half) { return d0 * 512 + ks * 4096 + half * 2048; }
__device__ __forceinline__ int crow(int r, int hi) { return (r & 3) + 8 * (r >> 2) + 4 * hi; }
__device__ __forceinline__ unsigned cvtpk(float lo, float hi) {
    unsigned r; asm volatile("v_cvt_pk_bf16_f32 %0, %1, %2" : "=v"(r) : "v"(lo), "v"(hi)); return r;
}
__device__ __forceinline__ bf16x8 pack8(f32x4 a, f32x4 b) {
    u32x4 w = {cvtpk(a[0], a[1]), cvtpk(a[2], a[3]), cvtpk(b[0], b[1]), cvtpk(b[2], b[3])};
    return *reinterpret_cast<bf16x8*>(&w);
}
template <class T> __device__ __forceinline__ bf16x8 load8(const T* p) {
    if constexpr (same_t<T, float>::v) { return pack8(*(const f32x4*)p, *(const f32x4*)(p + 4)); }
    else { return *reinterpret_cast<const bf16x8*>(p); }
}
__device__ __forceinline__ void mask_tile(f32x16& p0, f32x16& p1, int dq, unsigned W) {
    const float NEG = -__builtin_inff();
#pragma unroll
    for (int r = 0; r < 16; ++r) {
        const int c = (r & 3) + 8 * (r >> 2);
        if ((unsigned)(dq - c) >= W) p0[r] = NEG;
        if ((unsigned)(dq - c - 32) >= W) p1[r] = NEG;
    }
}
__device__ __forceinline__ void partialSM(f32x16& p0, f32x16& p1, float& m_reg, float& mn, float& alpha) {
    float pmax = p0[0]; for (int r = 1; r < 16; ++r) pmax = fmaxf(pmax, p0[r]); for (int r = 0; r < 16; ++r) pmax = fmaxf(pmax, p1[r]);
    { auto rr = __builtin_amdgcn_permlane32_swap(__float_as_uint(pmax), __float_as_uint(pmax), false, false);
      pmax = fmaxf(__uint_as_float(rr[0]), __uint_as_float(rr[1])); }
    constexpr float C2 = 1.4426950408889634f * SCALE;
    if (__builtin_expect(__all((pmax - m_reg) * SCALE <= THR), 1)) { mn = m_reg; alpha = 1.f; }
    else { mn = fmaxf(m_reg, pmax); alpha = __builtin_amdgcn_exp2f((m_reg - mn) * C2); m_reg = mn; }
    const float mnL = -mn * C2;
    for (int r = 0; r < 16; ++r) p0[r] = fmaf(p0[r], C2, mnL); for (int r = 0; r < 16; ++r) p1[r] = fmaf(p1[r], C2, mnL);
    for (int r = 0; r < 16; ++r) p0[r] = __builtin_amdgcn_exp2f(p0[r]);
}
__device__ __forceinline__ void finishSM(f32x16& p0, f32x16& p1, float alpha, float& l_reg, bf16x8& pa0, bf16x8& pa1, bf16x8& pa2, bf16x8& pa3) {
    for (int r = 0; r < 16; ++r) p1[r] = __builtin_amdgcn_exp2f(p1[r]);
    float ps = 0; for (int r = 0; r < 16; ++r) ps += p0[r]; for (int r = 0; r < 16; ++r) ps += p1[r];
    { auto rr = __builtin_amdgcn_permlane32_swap(__float_as_uint(ps), __float_as_uint(ps), false, false);
      ps = __uint_as_float(rr[0]) + __uint_as_float(rr[1]); }
    l_reg = l_reg * alpha + ps;
#define PK4(P, B_, OUT) do { unsigned a0 = cvtpk(P[B_+0], P[B_+1]), a1 = cvtpk(P[B_+2], P[B_+3]);                          \
        unsigned b0 = cvtpk(P[B_+4], P[B_+5]), b1 = cvtpk(P[B_+6], P[B_+7]);                                             \
        auto r0 = __builtin_amdgcn_permlane32_swap(a0, b0, false, false); auto r1 = __builtin_amdgcn_permlane32_swap(a1, b1, false, false); \
        u32x4 w = {r0[0], r1[0], r0[1], r1[1]}; OUT = *reinterpret_cast<bf16x8*>(&w); } while (0)
    PK4(p0, 0, pa0); PK4(p0, 8, pa1); PK4(p1, 0, pa2); PK4(p1, 8, pa3);
#undef PK4
}
template <int VB, bool SK>
__device__ __forceinline__ void pv_tile(f32x16* o, int vb0, bf16x8 pa0, bf16x8 pa1, bf16x8 pa2, bf16x8 pa3, bool act) {
    if (SK && !act) return;
#define TRRD(dst, off) asm volatile("ds_read_b64_tr_b16 %0, %1 offset:%2" : "=&v"(dst) : "v"(vb0), "i"(off) : "memory")
#define PV_D0(d0) do { s16x4 l0, l1, l2, l3, h0, h1, h2, h3; constexpr int b_ = VB * SHM_V + v_rd_off(d0, 0, 0);     \
        TRRD(l0, b_); TRRD(h0, b_ + 2048); TRRD(l1, b_ + 4096); TRRD(h1, b_ + 6144); TRRD(l2, b_ + 8192); TRRD(h2, b_ + 10240); TRRD(l3, b_ + 12288); TRRD(h3, b_ + 14336); \
        asm volatile("s_waitcnt lgkmcnt(0)" ::: "memory"); SBAR();                 \
        o[d0] = __builtin_amdgcn_mfma_f32_32x32x16_bf16(pa0, (bf16x8){l0[0], l0[1], l0[2], l0[3], h0[0], h0[1], h0[2], h0[3]}, o[d0], 0, 0, 0);   \
        o[d0] = __builtin_amdgcn_mfma_f32_32x32x16_bf16(pa1, (bf16x8){l1[0], l1[1], l1[2], l1[3], h1[0], h1[1], h1[2], h1[3]}, o[d0], 0, 0, 0);   \
        o[d0] = __builtin_amdgcn_mfma_f32_32x32x16_bf16(pa2, (bf16x8){l2[0], l2[1], l2[2], l2[3], h2[0], h2[1], h2[2], h2[3]}, o[d0], 0, 0, 0);   \
        o[d0] = __builtin_amdgcn_mfma_f32_32x32x16_bf16(pa3, (bf16x8){l3[0], l3[1], l3[2], l3[3], h3[0], h3[1], h3[2], h3[3]}, o[d0], 0, 0, 0); } while (0)
    PV_D0(0); PV_D0(1); PV_D0(2); PV_D0(3);
#undef PV_D0
#undef TRRD
}

template <int VB>
__device__ __forceinline__ void pv_tile2(f32x16* o, int vb0, bf16x8 pa0, bf16x8 pa1, bf16x8 pa2, bf16x8 pa3) {
#define TRRD(dst, off) asm volatile("ds_read_b64_tr_b16 %0, %1 offset:%2" : "=&v"(dst) : "v"(vb0), "i"(off) : "memory")
#define PV_RD(S, d0) do { constexpr int b_ = VB * SHM_V + v_rd_off(d0, 0, 0); \
        TRRD(l0##S, b_); TRRD(h0##S, b_ + 2048); TRRD(l1##S, b_ + 4096); TRRD(h1##S, b_ + 6144); TRRD(l2##S, b_ + 8192); TRRD(h2##S, b_ + 10240); TRRD(l3##S, b_ + 12288); TRRD(h3##S, b_ + 14336); } while (0)
#define PV_MM(S, d0) do { \
        o[d0] = __builtin_amdgcn_mfma_f32_32x32x16_bf16(pa0, (bf16x8){l0##S[0], l0##S[1], l0##S[2], l0##S[3], h0##S[0], h0##S[1], h0##S[2], h0##S[3]}, o[d0], 0, 0, 0);   \
        o[d0] = __builtin_amdgcn_mfma_f32_32x32x16_bf16(pa1, (bf16x8){l1##S[0], l1##S[1], l1##S[2], l1##S[3], h1##S[0], h1##S[1], h1##S[2], h1##S[3]}, o[d0], 0, 0, 0);   \
        o[d0] = __builtin_amdgcn_mfma_f32_32x32x16_bf16(pa2, (bf16x8){l2##S[0], l2##S[1], l2##S[2], l2##S[3], h2##S[0], h2##S[1], h2##S[2], h2##S[3]}, o[d0], 0, 0, 0);   \
        o[d0] = __builtin_amdgcn_mfma_f32_32x32x16_bf16(pa3, (bf16x8){l3##S[0], l3##S[1], l3##S[2], l3##S[3], h3##S[0], h3##S[1], h3##S[2], h3##S[3]}, o[d0], 0, 0, 0); } while (0)
    s16x4 l0a, l1a, l2a, l3a, h0a, h1a, h2a, h3a, l0b, l1b, l2b, l3b, h0b, h1b, h2b, h3b;
    PV_RD(a, 0); PV_RD(b, 1);
    asm volatile("s_waitcnt lgkmcnt(8)" ::: "memory"); SBAR(); PV_MM(a, 0); SBAR();
    PV_RD(a, 2);
    asm volatile("s_waitcnt lgkmcnt(8)" ::: "memory"); SBAR(); PV_MM(b, 1); SBAR();
    PV_RD(b, 3);
    asm volatile("s_waitcnt lgkmcnt(8)" ::: "memory"); SBAR(); PV_MM(a, 2); SBAR();
    asm volatile("s_waitcnt lgkmcnt(0)" ::: "memory"); SBAR(); PV_MM(b, 3);
#undef PV_MM
#undef PV_RD
#undef TRRD
}
template <int KB, bool HALFB>
__device__ __forceinline__ void qkt128(f32x16& p0, f32x16& p1, const char* K_lds, int r32, int hi, const bf16x8* qr, const f32x16& cinit) {
    const char* kb[4];
#pragma unroll
    for (int dd = 0; dd < 4; ++dd) kb[dd] = K_lds + KB * SHM_K + KSWZ(r32, (dd * 16 + hi * 8) * 2) + ((r32 >> 3) & 1) * 128;
    const int kdl = ((r32 >> 3) & 1) ? -128 : 128;
    if (HALFB) {
#pragma unroll
        for (int hb = 0; hb < 2; ++hb) { bf16x8 kf[8];
#pragma unroll
            for (int d = 0; d < 4; ++d) { const int d0 = hb * 4 + d; const char* a = kb[d0 & 3] + (d0 >> 2) * kdl;
                kf[2 * d] = *reinterpret_cast<const bf16x8*>(a); kf[2 * d + 1] = *reinterpret_cast<const bf16x8*>(a + 32 * 256); }
            SBAR();
#pragma unroll
            for (int d = 0; d < 4; ++d) { const int d0 = hb * 4 + d;
                p0 = __builtin_amdgcn_mfma_f32_32x32x16_bf16(kf[2 * d], qr[d0], d0 == 0 ? cinit : p0, 0, 0, 0);
                p1 = __builtin_amdgcn_mfma_f32_32x32x16_bf16(kf[2 * d + 1], qr[d0], d0 == 0 ? cinit : p1, 0, 0, 0); }
            SBAR(); }
    } else {
    bf16x8 kf[16];
#pragma unroll
    for (int d0 = 0; d0 < 8; ++d0) { const char* a = kb[d0 & 3] + (d0 >> 2) * kdl;
        kf[2 * d0] = *reinterpret_cast<const bf16x8*>(a); kf[2 * d0 + 1] = *reinterpret_cast<const bf16x8*>(a + 32 * 256); }
    SBAR();
#pragma unroll
    for (int d0 = 0; d0 < 8; ++d0) {
        p0 = __builtin_amdgcn_mfma_f32_32x32x16_bf16(kf[2 * d0], qr[d0], d0 == 0 ? cinit : p0, 0, 0, 0);
        p1 = __builtin_amdgcn_mfma_f32_32x32x16_bf16(kf[2 * d0 + 1], qr[d0], d0 == 0 ? cinit : p1, 0, 0, 0); }
    }
}
#define KSWZ64(row, colB) ((row) * 128 + ((colB) ^ (((row) & 7) << 4)))
template <int KB>
__device__ __forceinline__ void qkt64(f32x16& p0, f32x16& p1, const char* K_lds, int r32, int hi, const bf16x8* qr, const f32x16& cinit) {
    const int prow = (r32 & ~1) | ((r32 & 1) ^ ((r32 >> 3) & 1));
#pragma unroll
    for (int hb = 0; hb < 2; ++hb) { bf16x8 kf[4];
#pragma unroll
        for (int d = 0; d < 2; ++d) { const int d0 = hb * 2 + d; const char* a = K_lds + KB * SHM_K + prow * 128 + (((d0 * 16 + hi * 8) * 2) ^ ((r32 & 7) << 4));
            kf[2 * d] = *reinterpret_cast<const bf16x8*>(a); kf[2 * d + 1] = *reinterpret_cast<const bf16x8*>(a + 32 * 128); }
        SBAR();
#pragma unroll
        for (int d = 0; d < 2; ++d) { const int d0 = hb * 2 + d;
            p0 = __builtin_amdgcn_mfma_f32_32x32x16_bf16(kf[2 * d], qr[d0], d0 == 0 ? cinit : p0, 0, 0, 0);
            p1 = __builtin_amdgcn_mfma_f32_32x32x16_bf16(kf[2 * d + 1], qr[d0], d0 == 0 ? cinit : p1, 0, 0, 0); }
        SBAR(); }
}
__device__ __forceinline__ void partialSM2(f32x16& p0, f32x16& p1, float& m_ref, f32x16& negm, float& alpha) {
    float pmax = p0[0]; for (int r = 1; r < 16; ++r) pmax = fmaxf(pmax, p0[r]); for (int r = 0; r < 16; ++r) pmax = fmaxf(pmax, p1[r]);
    { auto rr = __builtin_amdgcn_permlane32_swap(__float_as_uint(pmax), __float_as_uint(pmax), false, false);
      pmax = fmaxf(__uint_as_float(rr[0]), __uint_as_float(rr[1])); }
    constexpr float THR2 = THR * 1.4426950408889634f;
    if (__builtin_expect(__all(pmax <= THR2), 1)) { alpha = 1.f; }
    else { const float dl = fmaxf(pmax, 0.f); m_ref += dl; alpha = __builtin_amdgcn_exp2f(-dl);
        for (int r = 0; r < 16; ++r) { p0[r] -= dl; p1[r] -= dl; }
        for (int r = 0; r < 16; ++r) negm[r] = -m_ref; }
    for (int r = 0; r < 16; ++r) p0[r] = __builtin_amdgcn_exp2f(p0[r]);
}
typedef unsigned short bfr;
constexpr int LDS_K = 0, LDS_V = 65536, LDS_WS = 131072, LDS_CK = 131072 + 2048, ATT_LDS = LDS_CK + 768;
struct Unit {
    const bfr* Q; const bfr* K; const bfr* V;
    long stride;
    int q0;
    int j_lo, j_hi;
    int W;
    const float* c;
};
__device__ __forceinline__ void normalize_o(f32x16 (&o)[4], float l_reg, char* lds, int wid, int r32, int hi);
__device__ __forceinline__ float* stage_o(f32x16 (&o)[4], char* lds, int wid, int ln);
#define ATT_LAS __attribute__((address_space(3)))
#ifdef PV_SINGLE
#define PVT(o_, vb_, a0, a1, a2, a3) pv_tile<0, false>(o_, vb_, a0, a1, a2, a3, true)
#else
#define PVT(o_, vb_, a0, a1, a2, a3) pv_tile2<0>(o_, vb_, a0, a1, a2, a3)
#endif
#ifndef NEGM_SEL
#define NEGM_SEL(DQK, FOX, SKIP) (!(FOX))
#endif
template <int DQK, bool FOX, bool SKIP>
__device__ __forceinline__ void unit_core(const Unit& U, char* lds, f32x16 (&o)[4], float& m_reg, float& l_reg,
                                          bf16x8 (&qr)[8], bool have_q, const bfr* nQ, long nstride, int nq0, int nfr) {
    int tid_l = threadIdx.x; asm volatile("" : "+v"(tid_l));
    const int tid = tid_l, wid = __builtin_amdgcn_readfirstlane(tid >> 6), lane = tid & 63, r32 = lane & 31, hi = lane >> 5;
    char* V_lds = lds + LDS_V; char* K_lds = lds + LDS_K;
    ATT_LAS unsigned char* lds3 = (ATT_LAS unsigned char*)(unsigned)(uintptr_t)lds;
    float* ws = (float*)(lds + LDS_WS) + wid * 64; float* al_l = ws + 32;
    float* ckl = (float*)(lds + LDS_CK);
    const int NT = U.j_hi - U.j_lo;
    const int qlo = U.q0 + wid * 32, qm = qlo + r32 - 4 * hi;
    int voff[2];
#pragma unroll
    for (int i = 0; i < 2; ++i) { const int p = (2 * wid + i) * 64 + lane, st = p >> 5, wi = p & 31, kk = (st >> 2) * 8 + (wi >> 2);
        const int key = (kk & ~0xC) | ((kk & 4) << 1) | ((kk & 8) >> 1); voff[i] = key * (int)U.stride + (st & 3) * 32 + (wi & 3) * 8; }
    int koff[2];
    if (DQK == 128) {
#pragma unroll
        for (int i = 0; i < 2; ++i) { const int p = (2 * wid + i) * 64 + lane, row = p >> 4, c = (p & 15) ^ ((row & 7) | (((row >> 3) & 1) << 3)); koff[i] = row * (int)U.stride + c * 8; }
    } else { const int p = wid * 64 + lane, prow = p >> 3, row = (prow & ~1) | ((prow & 1) ^ ((prow >> 3) & 1)), c = (p & 7) ^ (row & 7); koff[0] = row * (int)U.stride + c * 8; koff[1] = 0; }
    const long tstep = 64 * U.stride;
#define A_TIDX(t_) (FOX ? (U.j_hi - 1 - (t_)) : (U.j_lo + (t_)))
#define A_DMA_K(t_, kslot) do { const long tb__ = (long)A_TIDX(t_) * tstep; \
        if (DQK == 128) { _Pragma("unroll") for (int i = 0; i < 2; ++i) \
            __builtin_amdgcn_global_load_lds((const unsigned*)(U.K + tb__ + koff[i]), (ATT_LAS unsigned*)(lds3 + LDS_K + (kslot) * SHM_K + (2 * wid + i) * 1024), 16, 0, 0); } \
        else __builtin_amdgcn_global_load_lds((const unsigned*)(U.K + tb__ + koff[0]), (ATT_LAS unsigned*)(lds3 + LDS_K + (kslot) * SHM_K + wid * 1024), 16, 0, 0); } while (0)
#define A_DMA_V(t_, vslot, cslot) do { const long tb__ = (long)A_TIDX(t_) * tstep; \
        _Pragma("unroll") for (int i = 0; i < 2; ++i) \
            __builtin_amdgcn_global_load_lds((const unsigned*)(U.V + tb__ + voff[i]), (ATT_LAS unsigned*)(lds3 + LDS_V + (vslot) * SHM_V + (2 * wid + i) * 1024), 16, 0, 0); \
        if (FOX) { if (wid == 0) __builtin_amdgcn_global_load_lds((const unsigned*)(U.c + (long)A_TIDX(t_) * 64 + lane), (ATT_LAS unsigned*)(lds3 + LDS_CK + (cslot) * 256), 4, 0, 0); } } while (0)
#define A_DMA_VONLY(t_, vslot) do { const long tb__ = (long)A_TIDX(t_) * tstep; \
        _Pragma("unroll") for (int i = 0; i < 2; ++i) \
            __builtin_amdgcn_global_load_lds((const unsigned*)(U.V + tb__ + voff[i]), (ATT_LAS unsigned*)(lds3 + LDS_V + (vslot) * SHM_V + (2 * wid + i) * 1024), 16, 0, 0); } while (0)
#define A_DMA_CK(t_, cslot) do { if (FOX) { if (wid == 0) __builtin_amdgcn_global_load_lds((const unsigned*)(U.c + (long)A_TIDX(t_) * 64 + lane), (ATT_LAS unsigned*)(lds3 + LDS_CK + (cslot) * 256), 4, 0, 0); } } while (0)
#define A_ISSUE(t_) do { if ((t_) + 3 < NT) A_DMA_K((t_) + 3, (vc + 3) & 3); if ((t_) + 2 < NT) A_DMA_V((t_) + 2, (vc + 2) & 3, A_K2()); } while (0)
#define A_VMW(n) asm volatile("s_waitcnt vmcnt(" #n ") lgkmcnt(0)" ::: "memory")
#define A_WAITBAR(t_) do { const bool ik_ = (t_) + 3 < NT, iv_ = (t_) + 2 < NT; const bool w0_ = FOX && wid == 0; \
        if (ik_) { if (DQK == 128) { if (w0_) A_VMW(5); else A_VMW(4); } else { if (w0_) A_VMW(4); else A_VMW(3); } } \
        else if (iv_) { if (w0_) A_VMW(3); else A_VMW(2); } \
        else A_VMW(0); \
        __builtin_amdgcn_s_barrier(); asm volatile("" ::: "memory"); } while (0)
    if (!have_q) { const bfr* qp = U.Q + (long)(qlo + r32) * U.stride + hi * 8;
#pragma unroll
      for (int d0 = 0; d0 < DQK / 16; ++d0) qr[d0] = *reinterpret_cast<const bf16x8*>(qp + d0 * 16); }
    if (SKIP) { A_DMA_K(0, 0); A_DMA_VONLY(0, 0); } else { A_DMA_CK(0, 0); A_DMA_K(0, 0); A_DMA_VONLY(0, 0); }
    if (NT > 1) { A_DMA_K(1, 1); A_DMA_V(1, 1, 1); } if (NT > 2) A_DMA_K(2, 2);
#define A_QPF() do { if (nfr) { const bfr* qp_ = nQ + (long)(nq0 + wid * 32 + r32) * nstride + hi * 8; \
        _Pragma("unroll") for (int d0 = 0; d0 < 8; ++d0) { if (d0 < nfr) qr[d0] = *reinterpret_cast<const bf16x8*>(qp_ + d0 * 16); } } } while (0)
    float cqv = 0.f; if (FOX) cqv = U.c[qlo + r32];
    constexpr bool NEGM = NEGM_SEL(DQK, FOX, SKIP);
    m_reg = !NEGM ? -1e30f : 0.f; l_reg = 0.f;
    f32x16 negm = f32x16{};
#pragma unroll
    for (int d = 0; d < 4; ++d) o[d] = f32x16{};
    const int vb0 = (int)(uintptr_t)V_lds + v_rd_base(lane);
    { const bool w0_ = FOX && wid == 0;
      if (SKIP) { if (NT > 2) A_VMW(6); else if (NT > 1) A_VMW(4); else A_VMW(0); }
      else if (DQK == 128) { if (NT > 2) { if (w0_) A_VMW(9); else A_VMW(8); } else if (NT > 1) { if (w0_) A_VMW(7); else A_VMW(6); } else A_VMW(2); }
      else { if (NT > 2) A_VMW(6); else if (NT > 1) A_VMW(5); else A_VMW(2); }
      __builtin_amdgcn_s_barrier(); asm volatile("" ::: "memory"); }
    f32x16 pA0, pA1, pB0, pB1; bf16x8 pa0, pa1, pa2, pa3; float mnA = 0.f, mnB = 0.f, alA = 1.f, alB = 1.f; bool actA = false, actB = false;
    int kc = 0, vc = 0;
#define A_ACT(t_) (!SKIP || (((A_TIDX(t_) * 64 <= qlo + 31) && (A_TIDX(t_) * 64 + 63 + U.W > qlo))))
#define A_HEADS(PX0, PX1, mnX, alX, actX, t_, ks_) do { actX = A_ACT(t_); alX = 1.f; \
        if (!SKIP || actX) { \
            if (DQK == 128) qkt128<0, true>(PX0, PX1, K_lds + (ks_) * SHM_K, r32, hi, qr, negm); else qkt64<0>(PX0, PX1, K_lds + (ks_) * SHM_K, r32, hi, qr, negm); } } while (0)
#define A_HEAD(PX0, PX1, mnX, alX, actX, t_) A_HEADS(PX0, PX1, mnX, alX, actX, t_, vc)
#define A_SOFT1(PX0, PX1, mnX, alX, actX, t_) do { const int kb_ = A_TIDX(t_) * 64; \
        if (!SKIP || actX) { \
            if (FOX) { const float* ck_ = ckl + kc * 64 + 4 * hi; \
                _Pragma("unroll") for (int g = 0; g < 4; ++g) { const f32x4 c0 = *(const f32x4*)(ck_ + 8 * g); const f32x4 c1 = *(const f32x4*)(ck_ + 32 + 8 * g); \
                    _Pragma("unroll") for (int i = 0; i < 4; ++i) { PX0[4 * g + i] += cqv - c0[i]; PX1[4 * g + i] += cqv - c1[i]; } } } \
            if (kb_ + 63 > qlo || kb_ + U.W <= qlo + 31) mask_tile(PX0, PX1, qm - kb_, (unsigned)U.W); \
            if (!NEGM) partialSM(PX0, PX1, m_reg, mnX, alX); else partialSM2(PX0, PX1, m_reg, negm, alX); } } while (0)
#define A_TAIL(PY0, PY1, alY, actY, vslot) do { if (!SKIP || actY) { finishSM(PY0, PY1, alY, l_reg, pa0, pa1, pa2, pa3); SBAR(); PVT(o, vb0 + (vslot) * SHM_V, pa0, pa1, pa2, pa3); } } while (0)
#define A_RESC(alX) do { if (__any((alX) < 1.f)) { if (hi == 0) al_l[r32] = (alX); asm volatile("s_waitcnt lgkmcnt(0)" ::: "memory"); \
        _Pragma("unroll") for (int d_ = 0; d_ < 4; ++d_) _Pragma("unroll") for (int r = 0; r < 16; ++r) o[d_][r] *= al_l[crow(r, hi)]; } } while (0)
#define A_ROT() do { kc = (kc == 2) ? 0 : kc + 1; vc = (vc + 1) & 3; } while (0)
#define A_K2() ((kc == 0) ? 2 : kc - 1)
    if (SKIP) {
        for (int ts = 0; ts < NT; ++ts) {
            A_ISSUE(ts);
            if (A_ACT(ts)) { actA = true; A_HEAD(pA0, pA1, mnA, alA, actA, ts); A_SOFT1(pA0, pA1, mnA, alA, actA, ts); A_RESC(alA);
                finishSM(pA0, pA1, alA, l_reg, pa0, pa1, pa2, pa3); SBAR(); PVT(o, vb0 + vc * SHM_V, pa0, pa1, pa2, pa3); }
            A_WAITBAR(ts); A_ROT(); }
        A_QPF();
        normalize_o(o, l_reg, lds, wid, r32, hi); { int ln_ = lane; asm volatile("" : "+v"(ln_)); stage_o(o, lds, wid, ln_); }
        return;
    }
#define A_STEP_AB(PX0, PX1, mnX, alX, actX, PY0, PY1, mnY, alY, actY, t_) do { const int t__ = (t_); \
        A_ISSUE(t__); \
        SBAR(); if (grpA) { A_HEAD(PX0, PX1, mnX, alX, actX, t__); } SBAR(); \
        A_TAIL(PY0, PY1, alY, actY, (vc + 3) & 3); \
        A_SOFT1(PX0, PX1, mnX, alX, actX, t__); \
        A_RESC(alX); SBAR(); \
        if (!grpA && t__ + 1 < NT) { A_HEADS(PY0, PY1, mnY, alY, actY, t__ + 1, (vc + 1) & 3); } \
        A_WAITBAR(t__); A_ROT(); } while (0)
#define A_LOOP(STEPM) do { int t = 1; \
        for (; t + 1 < NT; t += 2) { \
            STEPM(pB0, pB1, mnB, alB, actB, pA0, pA1, mnA, alA, actA, t); \
            STEPM(pA0, pA1, mnA, alA, actA, pB0, pB1, mnB, alB, actB, t + 1); } \
        if (t < NT) { STEPM(pB0, pB1, mnB, alB, actB, pA0, pA1, mnA, alA, actA, t); pA0 = pB0; pA1 = pB1; alA = alB; actA = actB; } \
        A_QPF(); A_TAIL(pA0, pA1, alA, actA, (vc + 3) & 3); } while (0)
#define A_FIN() do { asm volatile("s_waitcnt lgkmcnt(0)" ::: "memory"); __builtin_amdgcn_s_barrier(); asm volatile("" ::: "memory"); \
        normalize_o(o, l_reg, lds, wid, r32, hi); { int ln_ = lane; asm volatile("" : "+v"(ln_)); stage_o(o, lds, wid, ln_); } } while (0)
    const bool grpA = true;
    { A_ISSUE(0);
      A_HEAD(pA0, pA1, mnA, alA, actA, 0); A_SOFT1(pA0, pA1, mnA, alA, actA, 0); SBAR();
      if (!grpA && NT > 1) { A_HEADS(pB0, pB1, mnB, alB, actB, 1, 1); }
      A_WAITBAR(0); A_ROT(); }
    A_LOOP(A_STEP_AB); A_FIN();
    return;
#undef A_FIN
#undef A_QPF
#undef A_LOOP
#undef A_STEP_AB
#undef A_K2
#undef A_ROT
#undef A_RESC
#undef A_TAIL
#undef A_SOFT1
#undef A_HEAD
#undef A_HEADS
#undef A_ACT
#undef A_WAITBAR
#undef A_ISSUE
#undef A_TIDX
#undef A_DMA_K
#undef A_DMA_V
#undef A_DMA_VONLY
#undef A_DMA_CK
#undef A_VMW
}
__device__ __forceinline__ void normalize_o(f32x16 (&o)[4], float l_reg, char* lds, int wid, int r32, int hi) {
    float* li_l = (float*)(lds + LDS_WS) + wid * 64;
    if (hi == 0) li_l[r32] = l_reg; asm volatile("s_waitcnt lgkmcnt(0)" ::: "memory");
#pragma unroll
    for (int r = 0; r < 16; ++r) { const float rl = __builtin_amdgcn_rcpf(li_l[crow(r, hi)]);
#pragma unroll
        for (int d = 0; d < 4; ++d) o[d][r] *= rl; }
    asm volatile("s_waitcnt lgkmcnt(0)" ::: "memory");
}
__device__ __forceinline__ float* stage_o(f32x16 (&o)[4], char* lds, int wid, int ln) {
    float* stg = (float*)(lds + wid * 16384);
    float* wb = stg + (ln >> 5) * 512 + (ln & 31);
#pragma unroll
    for (int r = 0; r < 16; ++r)
#pragma unroll
        for (int d0 = 0; d0 < 4; ++d0) wb[((r & 3) + 8 * (r >> 2)) * 128 + d0 * 32] = o[d0][r];
    asm volatile("s_waitcnt lgkmcnt(0)" ::: "memory");
    return stg;
}
__device__ __forceinline__ f32x4 stg_chunk(const float* stg, int row, int half, int j) { return *(const f32x4*)(stg + row * 128 + half * 64 + 4 * j); }
}
constexpr int BATCH = 8, SEQ = 4096, DM = 1024, TOK = BATCH * SEQ, PLE = 256, EVEN_IN = 4100, NPROJ = 4096;
constexpr float RMS_EPS = 1e-6f, LAM_INIT0 = 0.2f;
constexpr size_t MiB = 1u << 20;
constexpr size_t WS_RSTD0 = 0, WS_LF = 256 * 1024, WS_C = 1 * MiB, WS_SSQ = 2 * MiB, WS_LSE = 4 * MiB, WS_BAR = 7 * MiB, BAR_BYTES = 16384;
constexpr size_t WS_W0T = 8 * MiB, WS_W1T = 16 * MiB, WS_WO0T = 24 * MiB, WS_WO1T = 26 * MiB, WS_WG0T = 28 * MiB, WS_WG1T = 30 * MiB, WS_WP0T = 32 * MiB, WS_WP1T = 32 * MiB + 512 * 1024;
constexpr size_t WS_PB = 34 * MiB, WS_A = 50 * MiB, WS_B = 114 * MiB, WS_CC = 178 * MiB, WS_PROJ = 242 * MiB, WS_ROPE = 498 * MiB, WS_END = 502 * MiB;
constexpr int LDS_BYTES = 147456, LDS_XCH = 135168;
typedef unsigned short bfr;
typedef float f32x4 __attribute__((ext_vector_type(4)));
typedef unsigned u32x4 __attribute__((ext_vector_type(4)));
typedef unsigned u32x2 __attribute__((ext_vector_type(2)));

struct Params {
    const float* x; const float* p; const int* positions; const float* norm_g; const float* w_in_even; const float* b_forget;
    const float* qn_a; const float* kn_a; const float* qn_b; const float* kn_b; const float* lam_q1; const float* lam_k1; const float* lam_q2; const float* lam_k2;
    const float* subln_g; const float* w_out_even; const float* w_in_odd; const float* qn_c; const float* kn_c; const float* w_out_odd; const float* w_ple; const float* w_ple_gate;
    float* out; unsigned char* ws;
};

__device__ __forceinline__ unsigned cvtpk(float lo, float hi) { unsigned r; asm volatile("v_cvt_pk_bf16_f32 %0, %1, %2" : "=v"(r) : "v"(lo), "v"(hi)); return r; }
__device__ __forceinline__ float bf2f(unsigned short b) { return __uint_as_float((unsigned)b << 16); }
__device__ __forceinline__ float shx(float v, int mask, int ln) { return __int_as_float(__builtin_amdgcn_ds_bpermute((ln ^ mask) << 2, __float_as_int(v))); }
__device__ __forceinline__ float wave_sum(float v, int ln) {
#pragma unroll
    for (int o = 1; o < 64; o <<= 1) v += shx(v, o, ln);
    return v;
}
__device__ __forceinline__ float silu_f(float z) { return z / (1.f + __expf(-z)); }
#ifdef V_FASTSIG
__device__ __forceinline__ float sigmoid_f(float z) { return __builtin_amdgcn_rcpf(1.f + __builtin_amdgcn_exp2f(-1.4426950408889634f * z)); }
#else
__device__ __forceinline__ float sigmoid_f(float z) { return 1.f / (1.f + __expf(-z)); }
#endif

struct EpiProj {
    static constexpr bool PERM = true, AFTER_DRAIN = false;
    bfr* O; int ldc; const float* rstd; const float* ssqp;
    __device__ __forceinline__ void operator()(const pg8::f32x4 (&acc)[2][2][4][2], const pg8::Unit& u, int wr, int wc, int fr, int fq) const {
        int fr_ = fr, fq_ = fq; asm volatile("" : "+v"(fr_), "+v"(fq_));
        const int row0 = u.pm * 256 + wr * 64 + fr_;
        bfr* Ob = O + (size_t)u.pm * 256 * ldc + u.pn * 256; const unsigned loff = (unsigned)(wr * 64 + fr_) * (unsigned)ldc + (unsigned)(wc * 32 + 8 * fq_);
#pragma unroll
        for (int ai = 0; ai < 2; ++ai)
#pragma unroll
            for (int m = 0; m < 4; ++m) { const int row = row0 + ai * 128 + m * 16; float rs;
                if (ssqp) { const f32x4* sp = (const f32x4*)(ssqp + (unsigned)row * 16u); const f32x4 a = sp[0], b = sp[1], c = sp[2], d = sp[3];
                    const float s = ((a[0] + a[1]) + (a[2] + a[3])) + ((b[0] + b[1]) + (b[2] + b[3])) + ((c[0] + c[1]) + (c[2] + c[3])) + ((d[0] + d[1]) + (d[2] + d[3]));
                    rs = __builtin_amdgcn_rsqf(s * (1.f / 1024.f) + RMS_EPS); }
                else rs = rstd[row];
                bfr* rowp = Ob + (loff + (unsigned)(ai * 128 + m * 16) * (unsigned)ldc);
#pragma unroll
                for (int bj = 0; bj < 2; ++bj) { const pg8::f32x4 v0 = acc[ai][bj][m][0] * rs, v1 = acc[ai][bj][m][1] * rs;
                    u32x4 w; w.x = cvtpk(v0[0], v0[1]); w.y = cvtpk(v0[2], v0[3]); w.z = cvtpk(v1[0], v1[1]); w.w = cvtpk(v1[2], v1[3]);
                    *(u32x4*)(rowp + bj * 128) = w; }
                asm volatile("" ::: "memory"); }
    }
};
template <int LAYER>
struct EpiProjNR {
    static constexpr bool PERM = true, AFTER_DRAIN = false;
    bfr* O; const float* rstd; const float* ssqp; const float* rope; const float* g_q64; const float* g_k64; const float* g_q128; const float* g_k128; float* xch;
    __device__ __forceinline__ void operator()(const pg8::f32x4 (&acc)[2][2][4][2], const pg8::Unit& u, int wr, int wc, int fr, int fq) const {
        int fr_ = fr, fq_ = fq; asm volatile("" : "+v"(fr_), "+v"(fq_));
        const int ln = fq_ * 16 + fr_, rl0 = wr * 64 + fr_, row0 = u.pm * 256 + rl0;
        int gw = 0; const float* gain = nullptr; float scale = 1.f; bool rope_t = false;
        if (LAYER == 0) {
            if (u.pn < 2) { gw = 64; gain = g_q64; scale = 0.125f * 1.4426950408889634f; rope_t = true; }
            else if (u.pn < 4) { gw = 64; gain = g_k64; rope_t = true; }
            else if (u.pn == 6 || u.pn == 7) { gw = 128; gain = g_q128; scale = 0.08838834764831845f * 1.4426950408889634f; }
            else if (u.pn == 8 || u.pn == 9) { gw = 128; gain = g_k128; }
        } else {
            if (u.pn < 4) { gw = 128; gain = g_q128; scale = 0.08838834764831845f * 1.4426950408889634f; rope_t = true; }
            else if (u.pn < 8) { gw = 128; gain = g_k128; rope_t = true; }
        }
        bfr* Ob = O + (size_t)u.pm * 256 * NPROJ + u.pn * 256; const unsigned loff = (unsigned)rl0 * (unsigned)NPROJ + (unsigned)(wc * 32 + 8 * fq_);
        float rs[8];
#pragma unroll
        for (int ai = 0; ai < 2; ++ai) {
            if (ssqp) { f32x4 pv[4][4];
#pragma unroll
                for (int m = 0; m < 4; ++m) { const f32x4* sp = (const f32x4*)(ssqp + (unsigned)(row0 + ai * 128 + m * 16) * 16u); pv[m][0] = sp[0]; pv[m][1] = sp[1]; pv[m][2] = sp[2]; pv[m][3] = sp[3]; }
#pragma unroll
                for (int m = 0; m < 4; ++m) { const f32x4 a = pv[m][0], b = pv[m][1], c = pv[m][2], d = pv[m][3];
                    const float sm = ((a[0] + a[1]) + (a[2] + a[3])) + ((b[0] + b[1]) + (b[2] + b[3])) + ((c[0] + c[1]) + (c[2] + c[3])) + ((d[0] + d[1]) + (d[2] + d[3]));
                    rs[ai * 4 + m] = __builtin_amdgcn_rsqf(sm * (1.f / 1024.f) + RMS_EPS); } }
            else {
#pragma unroll
                for (int m = 0; m < 4; ++m) rs[ai * 4 + m] = rstd[row0 + ai * 128 + m * 16]; }
            asm volatile("" ::: "memory"); }
        if (gw == 0) {
#pragma unroll
            for (int ai = 0; ai < 2; ++ai)
#pragma unroll
                for (int m = 0; m < 4; ++m) { bfr* rowp = Ob + (loff + (unsigned)(ai * 128 + m * 16) * (unsigned)NPROJ); const float r = rs[ai * 4 + m];
#pragma unroll
                    for (int bj = 0; bj < 2; ++bj) { const pg8::f32x4 v0 = acc[ai][bj][m][0] * r, v1 = acc[ai][bj][m][1] * r;
                        u32x4 w; w.x = cvtpk(v0[0], v0[1]); w.y = cvtpk(v0[2], v0[3]); w.z = cvtpk(v1[0], v1[1]); w.w = cvtpk(v1[2], v1[3]);
                        *(u32x4*)(rowp + bj * 128) = w; } }
            return;
        }
#pragma unroll
        for (int ai = 0; ai < 2; ++ai)
#pragma unroll
            for (int m = 0; m < 4; ++m) { const float r = rs[ai * 4 + m];
#pragma unroll
                for (int bj = 0; bj < 2; ++bj) { const pg8::f32x4 v0 = acc[ai][bj][m][0] * r, v1 = acc[ai][bj][m][1] * r;
                    float ss = (v0[0] * v0[0] + v0[1] * v0[1]) + (v0[2] * v0[2] + v0[3] * v0[3]) + (v1[0] * v1[0] + v1[1] * v1[1]) + (v1[2] * v1[2] + v1[3] * v1[3]);
                    ss += shx(ss, 16, ln); ss += shx(ss, 32, ln);
                    if (fq_ == 0) xch[(rl0 + ai * 128 + m * 16) * 8 + bj * 4 + wc] = ss; } }
        asm volatile("s_waitcnt lgkmcnt(0)" ::: "memory"); __builtin_amdgcn_s_barrier(); asm volatile("" ::: "memory");
        const int cig = (gw == 128) ? (wc * 32 + 8 * fq_) : ((wc & 1) * 32 + 8 * fq_);
        float gn[8];
        { const f32x4 ga = *(const f32x4*)(gain + cig), gb = *(const f32x4*)(gain + cig + 4); gn[0] = ga[0]; gn[1] = ga[1]; gn[2] = ga[2]; gn[3] = ga[3]; gn[4] = gb[0]; gn[5] = gb[1]; gn[6] = gb[2]; gn[7] = gb[3]; }
        const bool rope_w = rope_t && ((gw == 128) ? (wc == 0) : ((wc & 1) == 0));
        const bool rope_l = (gw == 128) ? true : (fq_ < 2);
        const bool isx2 = (gw == 128) ? (fq_ >= 2) : (fq_ == 1);
        const int pd = (gw == 128) ? 32 : 16;
        const float inv_gw = (gw == 128) ? (1.f / 128.f) : (1.f / 64.f);
#pragma unroll
        for (int ap = 0; ap < 4; ++ap) { const int ai = ap >> 1, mb = (ap & 1) * 2;
            float cs[2][8], sn[2][8];
            if (rope_w) {
#pragma unroll
                for (int mm = 0; mm < 2; ++mm) { const int m = mm; const float* tb = rope + (size_t)(u.pm * 256 + rl0 + ai * 128 + (mb + mm) * 16) * 32;
                    if (gw == 128) { const int ib = (fq_ & 1) * 8; const f32x4 c0 = *(const f32x4*)(tb + ib), c1 = *(const f32x4*)(tb + ib + 4), s0 = *(const f32x4*)(tb + 16 + ib), s1 = *(const f32x4*)(tb + 16 + ib + 4);
#pragma unroll
                        for (int j = 0; j < 4; ++j) { cs[m][j] = c0[j]; cs[m][4 + j] = c1[j]; sn[m][j] = s0[j]; sn[m][4 + j] = s1[j]; } }
                    else { const f32x4 c0 = *(const f32x4*)(tb), c1 = *(const f32x4*)(tb + 4), c2 = *(const f32x4*)(tb + 8), c3 = *(const f32x4*)(tb + 12);
                        const f32x4 s0 = *(const f32x4*)(tb + 16), s1 = *(const f32x4*)(tb + 20), s2 = *(const f32x4*)(tb + 24), s3 = *(const f32x4*)(tb + 28);
                        cs[m][0] = c0[0]; cs[m][1] = c0[2]; cs[m][2] = c1[0]; cs[m][3] = c1[2]; cs[m][4] = c2[0]; cs[m][5] = c2[2]; cs[m][6] = c3[0]; cs[m][7] = c3[2];
                        sn[m][0] = s0[0]; sn[m][1] = s0[2]; sn[m][2] = s1[0]; sn[m][3] = s1[2]; sn[m][4] = s2[0]; sn[m][5] = s2[2]; sn[m][6] = s3[0]; sn[m][7] = s3[2]; } } }
#pragma unroll
            for (int mm = 0; mm < 2; ++mm) { const int m = mb + mm; const int rl = rl0 + ai * 128 + m * 16; const float r = rs[ai * 4 + m];
#pragma unroll
                for (int bj = 0; bj < 2; ++bj) {
                    float sq;
                    if (gw == 128) { const f32x4 x = *(const f32x4*)(xch + rl * 8 + bj * 4); sq = (x[0] + x[1]) + (x[2] + x[3]); }
                    else { const float* xp = xch + rl * 8 + bj * 4 + (wc & 2); sq = xp[0] + xp[1]; }
                    const float f = r * __builtin_amdgcn_rsqf(sq * inv_gw + RMS_EPS);
                    float v[8];
#pragma unroll
                    for (int j = 0; j < 4; ++j) { v[j] = acc[ai][bj][m][0][j] * f * gn[j]; v[4 + j] = acc[ai][bj][m][1][j] * f * gn[4 + j]; }
                    if (rope_w) { float pr[8];
#pragma unroll
                        for (int j = 0; j < 8; ++j) pr[j] = shx(v[j], pd, ln);
                        if (rope_l) {
#pragma unroll
                            for (int j = 0; j < 8; ++j) v[j] = isx2 ? (v[j] * cs[mm][j] + pr[j] * sn[mm][j]) : (v[j] * cs[mm][j] - pr[j] * sn[mm][j]); } }
                    u32x4 w; w.x = cvtpk(v[0] * scale, v[1] * scale); w.y = cvtpk(v[2] * scale, v[3] * scale); w.z = cvtpk(v[4] * scale, v[5] * scale); w.w = cvtpk(v[6] * scale, v[7] * scale);
                    *(u32x4*)(Ob + (loff + (unsigned)(ai * 128 + m * 16) * (unsigned)NPROJ) + bj * 128) = w; } }
            asm volatile("" ::: "memory"); }
    }
};
template <bool BASE_BF16>
struct EpiRes {
    static constexpr bool PERM = true, AFTER_DRAIN = false;
    const float* basef; const bfr* baseh; bfr* hb;
    __device__ __forceinline__ void operator()(const pg8::f32x4 (&acc)[2][2][4][2], const pg8::Unit& u, int wr, int wc, int fr, int fq) const {
        int fr_ = fr, fq_ = fq; asm volatile("" : "+v"(fr_), "+v"(fq_));
        const size_t ub = (size_t)u.pm * 256 * DM + u.pn * 256; const float* bfb = basef + ub; const bfr* bhb = baseh + ub; bfr* hbb = hb + ub;
        const unsigned loff = (unsigned)(wr * 64 + fr_) * DM + (unsigned)(wc * 32 + 8 * fq_);
#pragma unroll
        for (int ai = 0; ai < 2; ++ai)
#pragma unroll
            for (int m = 0; m < 4; ++m) { const unsigned off = loff + (unsigned)(ai * 128 + m * 16) * DM;
#pragma unroll
                for (int bj = 0; bj < 2; ++bj) { const unsigned o2 = off + bj * 128; f32x4 b0, b1;
                    if (BASE_BF16) { const u32x4 bw = *(const u32x4*)(bhb + o2);
                        b0[0] = __uint_as_float(bw.x << 16); b0[1] = __uint_as_float(bw.x & 0xffff0000u); b0[2] = __uint_as_float(bw.y << 16); b0[3] = __uint_as_float(bw.y & 0xffff0000u);
                        b1[0] = __uint_as_float(bw.z << 16); b1[1] = __uint_as_float(bw.z & 0xffff0000u); b1[2] = __uint_as_float(bw.w << 16); b1[3] = __uint_as_float(bw.w & 0xffff0000u); }
                    else { b0 = *(const f32x4*)(bfb + o2); b1 = *(const f32x4*)(bfb + o2 + 4); }
                    const f32x4 v0 = b0 + acc[ai][bj][m][0], v1 = b1 + acc[ai][bj][m][1];
                    u32x4 w; w.x = cvtpk(v0[0], v0[1]); w.y = cvtpk(v0[2], v0[3]); w.z = cvtpk(v1[0], v1[1]); w.w = cvtpk(v1[2], v1[3]);
                    *(u32x4*)(hbb + o2) = w; }
                asm volatile("" ::: "memory"); }
    }
};
struct EpiT1 {
    static constexpr bool PERM = true, AFTER_DRAIN = false;
    bfr* t1;
    __device__ __forceinline__ void operator()(const pg8::f32x4 (&acc)[2][2][4][2], const pg8::Unit& u, int wr, int wc, int fr, int fq) const {
        int fr_ = fr, fq_ = fq; asm volatile("" : "+v"(fr_), "+v"(fq_));
        bfr* tb = t1 + (size_t)u.pm * 256 * DM + u.pn * 256; const unsigned loff = (unsigned)(wr * 64 + fr_) * DM + (unsigned)(wc * 32 + 8 * fq_);
#pragma unroll
        for (int ai = 0; ai < 2; ++ai)
#pragma unroll
            for (int m = 0; m < 4; ++m) { const unsigned off = loff + (unsigned)(ai * 128 + m * 16) * DM;
#pragma unroll
                for (int bj = 0; bj < 2; ++bj) { const pg8::f32x4 v0 = acc[ai][bj][m][0], v1 = acc[ai][bj][m][1];
                    u32x4 w; w.x = cvtpk(v0[0], v0[1]); w.y = cvtpk(v0[2], v0[3]); w.z = cvtpk(v1[0], v1[1]); w.w = cvtpk(v1[2], v1[3]);
                    *(u32x4*)(tb + off + bj * 128) = w; }
                asm volatile("" ::: "memory"); }
    }
};
struct EpiGate {
    static constexpr bool PERM = true, AFTER_DRAIN = false;
    const bfr* hin; const bfr* t1; bfr* hb2; float* ssqp; float* fout;
    __device__ __forceinline__ void operator()(const pg8::f32x4 (&acc)[2][2][4][2], const pg8::Unit& u, int wr, int wc, int fr, int fq) const {
        int fr_ = fr, fq_ = fq; asm volatile("" : "+v"(fr_), "+v"(fq_));
        const int row0 = u.pm * 256 + wr * 64 + fr_;
        const size_t ub = (size_t)u.pm * 256 * DM + u.pn * 256; const bfr* hbp = hin + ub; const bfr* t1b = t1 + ub; bfr* hb2b = hb2 ? hb2 + ub : nullptr; float* fo = fout ? fout + ub : nullptr;
        const unsigned loff = (unsigned)(wr * 64 + fr_) * DM + (unsigned)(wc * 32 + 8 * fq_);
#pragma unroll
        for (int ai = 0; ai < 2; ++ai)
#pragma unroll
            for (int m = 0; m < 4; ++m) { const int row = row0 + ai * 128 + m * 16; const unsigned off = loff + (unsigned)(ai * 128 + m * 16) * DM; float ss = 0.f;
#pragma unroll
                for (int bj = 0; bj < 2; ++bj) { const unsigned o2 = off + bj * 128;
                    const u32x4 bw = *(const u32x4*)(hbp + o2); const u32x4 tw = *(const u32x4*)(t1b + o2);
                    const float bb[8] = {__uint_as_float(bw.x << 16), __uint_as_float(bw.x & 0xffff0000u), __uint_as_float(bw.y << 16), __uint_as_float(bw.y & 0xffff0000u),
                                         __uint_as_float(bw.z << 16), __uint_as_float(bw.z & 0xffff0000u), __uint_as_float(bw.w << 16), __uint_as_float(bw.w & 0xffff0000u)};
                    const float tt[8] = {__uint_as_float(tw.x << 16), __uint_as_float(tw.x & 0xffff0000u), __uint_as_float(tw.y << 16), __uint_as_float(tw.y & 0xffff0000u),
                                         __uint_as_float(tw.z << 16), __uint_as_float(tw.z & 0xffff0000u), __uint_as_float(tw.w << 16), __uint_as_float(tw.w & 0xffff0000u)};
                    f32x4 v0, v1;
#pragma unroll
                    for (int i = 0; i < 4; ++i) { v0[i] = bb[i] + tt[i] * sigmoid_f(acc[ai][bj][m][0][i]); v1[i] = bb[4 + i] + tt[4 + i] * sigmoid_f(acc[ai][bj][m][1][i]); }
                    if (fout) { __builtin_nontemporal_store(v0, (f32x4*)(fo + o2)); __builtin_nontemporal_store(v1, (f32x4*)(fo + o2 + 4)); }
                    if (hb2) { u32x4 w; w.x = cvtpk(v0[0], v0[1]); w.y = cvtpk(v0[2], v0[3]); w.z = cvtpk(v1[0], v1[1]); w.w = cvtpk(v1[2], v1[3]); *(u32x4*)(hb2b + o2) = w; }
                    ss += (v0[0] * v0[0] + v0[1] * v0[1]) + (v0[2] * v0[2] + v0[3] * v0[3]) + (v1[0] * v1[0] + v1[1] * v1[1]) + (v1[2] * v1[2] + v1[3] * v1[3]); }
                if (ssqp) { const int ln_ = fq_ * 16 + fr_;
                    ss += __int_as_float(__builtin_amdgcn_ds_bpermute((ln_ ^ 16) << 2, __float_as_int(ss))); ss += __int_as_float(__builtin_amdgcn_ds_bpermute((ln_ ^ 32) << 2, __float_as_int(ss))); if (fq_ == 0) ssqp[(unsigned)row * 16u + (unsigned)(u.pn * 4 + wc)] = ss; }
                asm volatile("" ::: "memory"); }
    }
};

__device__ __forceinline__ void transpose_item(const float* W, int ldw, int csrc, int K, int ncols, const float* g, bfr* WT, int row_off, float* scr, int item, int lane) {
    const int nblk = ncols / 32, kb = item / nblk, nb = item % nblk, k0 = 64 * kb, n0 = 32 * nb;
#pragma unroll 8
    for (int i = 0; i < 32; ++i) { const int kk = 2 * i + (lane >> 5); float v = __builtin_nontemporal_load(W + (size_t)(k0 + kk) * ldw + csrc + n0 + (lane & 31)); if (g) v *= g[k0 + kk]; scr[kk * 33 + (lane & 31)] = v; }
    asm volatile("s_waitcnt lgkmcnt(0)" ::: "memory");
    const int c = lane & 7;
#pragma unroll
    for (int j = 0; j < 4; ++j) { const int n = (lane >> 3) + 8 * j; const float* s = scr + (8 * c) * 33 + n;
        u32x4 o; o.x = cvtpk(s[0 * 33], s[1 * 33]); o.y = cvtpk(s[2 * 33], s[3 * 33]); o.z = cvtpk(s[4 * 33], s[5 * 33]); o.w = cvtpk(s[6 * 33], s[7 * 33]);
        *(u32x4*)(WT + (size_t)(row_off + n0 + n) * K + k0 + 8 * c) = o; }
    asm volatile("s_waitcnt lgkmcnt(0)" ::: "memory");
}

__device__ __forceinline__ void phase_prologue(const Params& P, char* lds, int G, int blk) {
    unsigned char* ws = P.ws;
    int tid_l = threadIdx.x; asm volatile("" : "+v"(tid_l));
    const int tid = tid_l, lane = tid & 63, wave = tid >> 6;
    const int gw = blk * 8 + wave, NGW = G * 8;
    float* wfs = (float*)(lds + 98304);
    for (int k = tid; k < DM; k += 512) { const f32x4 w = *(const f32x4*)(P.w_in_even + (size_t)k * EVEN_IN + 3072); const float g = P.norm_g[k]; *(f32x4*)(wfs + 4 * k) = w * g; }
    __syncthreads();
    bfr* xb = (bfr*)(ws + WS_A); float* rstd0 = (float*)(ws + WS_RSTD0); float* lf = (float*)(ws + WS_LF);
    const float bf0 = P.b_forget[0], bf1 = P.b_forget[1], bf2 = P.b_forget[2], bf3 = P.b_forget[3];
    for (int m0 = gw; m0 < TOK; m0 += 2 * NGW) {
        f32x4 vv[2][4];
#pragma unroll
        for (int q = 0; q < 2; ++q) { const int m = m0 + q * NGW; if (m < TOK) { const f32x4* xr = (const f32x4*)(P.x + (size_t)m * DM) + lane;
#pragma unroll
            for (int j = 0; j < 4; ++j) vv[q][j] = __builtin_nontemporal_load(xr + 64 * j); } }
#pragma unroll
        for (int q = 0; q < 2; ++q) { const int m = m0 + q * NGW; if (m >= TOK) break;
        f32x4 v[4]; float ss = 0.f; f32x4 fa = {0.f, 0.f, 0.f, 0.f};
#pragma unroll
        for (int j = 0; j < 4; ++j) { v[j] = vv[q][j]; ss += (v[j][0] * v[j][0] + v[j][1] * v[j][1]) + (v[j][2] * v[j][2] + v[j][3] * v[j][3]);
#pragma unroll
            for (int i = 0; i < 4; ++i) { const f32x4 w = *(const f32x4*)(wfs + 4 * (256 * j + 4 * lane + i)); fa += w * v[j][i]; } }
        ss = wave_sum(ss, lane); const float rs = __builtin_amdgcn_rsqf(ss * (1.f / DM) + RMS_EPS);
        fa[0] = wave_sum(fa[0], lane); fa[1] = wave_sum(fa[1], lane); fa[2] = wave_sum(fa[2], lane); fa[3] = wave_sum(fa[3], lane);
        unsigned long long* o8 = (unsigned long long*)(xb + (size_t)m * DM) + lane;
#pragma unroll
        for (int j = 0; j < 4; ++j) o8[64 * j] = (unsigned long long)cvtpk(v[j][0], v[j][1]) | ((unsigned long long)cvtpk(v[j][2], v[j][3]) << 32);
        if (lane < 4) { const float y = (lane == 0 ? fa[0] : lane == 1 ? fa[1] : lane == 2 ? fa[2] : fa[3]) * rs + (lane == 0 ? bf0 : lane == 1 ? bf1 : lane == 2 ? bf2 : bf3);
            const float ls = fminf(y, 0.f) - log1pf(__expf(-fabsf(y)));
            const int b = m / SEQ, s = m % SEQ; lf[(size_t)(b * 4 + lane) * SEQ + s] = ls; }
        if (lane == 0) rstd0[m] = rs; }
    }
    { float* rope = (float*)(ws + WS_ROPE);
      for (int e = blk * 512 + tid; e < TOK * 16; e += G * 512) { const int t = e >> 4, i = e & 15;
          const float invf = expf(-13.122363377404328f * (float)i / 16.f), ang = (float)P.positions[t] * invf;
          const double rev = (double)ang * 0.15915494309189535; const float fr = (float)(rev - rint(rev));
          rope[t * 32 + i] = __builtin_amdgcn_cosf(fr); rope[t * 32 + 16 + i] = __builtin_amdgcn_sinf(fr); } }
    __syncthreads();
    float* scr = (float*)(lds + wave * 16384);
    constexpr int I0 = 16 * 96, I1 = 16 * 32, I2 = 512, I3 = 16 * 128, I4 = 512, I5 = 512, I6 = 512, I7 = 128, I8 = 128;
    for (int it = gw; it < I0 + I1; it += NGW) { int r = it;
        if (r < I0) { transpose_item(P.w_in_even, EVEN_IN, 0, DM, 3072, P.norm_g, (bfr*)(ws + WS_W0T), 0, scr, r, lane); continue; } r -= I0;
        transpose_item(P.w_in_even, EVEN_IN, 3076, DM, 1024, P.norm_g, (bfr*)(ws + WS_W0T), 3072, scr, r, lane);
    }
}
__device__ __forceinline__ void phase_late_weights(const Params& P, char* lds, int G, int blk) {
    unsigned char* ws = P.ws;
    int tid_l = threadIdx.x; asm volatile("" : "+v"(tid_l));
    const int tid = tid_l, lane = tid & 63, wave = tid >> 6;
    const int gw = blk * 8 + wave, NGW = G * 8;
    float* scr = (float*)(lds + wave * 16384);
    constexpr int I2 = 512, I3 = 16 * 128, I4 = 512, I5 = 512, I6 = 512, I7 = 128, I8 = 128;
    constexpr int NIT = I2 + I3 + I4 + I5 + I6 + I7 + I8;
    for (int it = gw; it < NIT; it += NGW) { int r = it;
        if (r < I2) { transpose_item(P.w_out_even, DM, 0, DM, DM, nullptr, (bfr*)(ws + WS_WO0T), 0, scr, r, lane); continue; } r -= I2;
        if (r < I3) { transpose_item(P.w_in_odd, NPROJ, 0, DM, NPROJ, P.norm_g + DM, (bfr*)(ws + WS_W1T), 0, scr, r, lane); continue; } r -= I3;
        if (r < I4) { transpose_item(P.w_out_odd, DM, 0, DM, DM, nullptr, (bfr*)(ws + WS_WO1T), 0, scr, r, lane); continue; } r -= I4;
        if (r < I5) { transpose_item(P.w_ple_gate, DM, 0, DM, DM, nullptr, (bfr*)(ws + WS_WG0T), 0, scr, r, lane); continue; } r -= I5;
        if (r < I6) { transpose_item(P.w_ple_gate + (size_t)DM * DM, DM, 0, DM, DM, nullptr, (bfr*)(ws + WS_WG1T), 0, scr, r, lane); continue; } r -= I6;
        if (r < I7) { transpose_item(P.w_ple, DM, 0, PLE, DM, nullptr, (bfr*)(ws + WS_WP0T), 0, scr, r, lane); continue; } r -= I7;
        transpose_item(P.w_ple + (size_t)PLE * DM, DM, 0, PLE, DM, nullptr, (bfr*)(ws + WS_WP1T), 0, scr, r, lane);
    }
    __syncthreads();
}
__device__ __forceinline__ void convert_p(const float* p, bfr* pb, int G, int blk) {
    const size_t n8 = (size_t)TOK * PLE / 8;
    int tid_l = threadIdx.x; asm volatile("" : "+v"(tid_l));
    const size_t stride = (size_t)G * 512;
    for (size_t i0 = (size_t)blk * 512 + tid_l; i0 < n8; i0 += 4 * stride) {
        f32x4 av[4], bv[4];
#pragma unroll
        for (int q = 0; q < 4; ++q) { const size_t i = i0 + q * stride; if (i < n8) { av[q] = __builtin_nontemporal_load((const f32x4*)(p + 8 * i)); bv[q] = __builtin_nontemporal_load((const f32x4*)(p + 8 * i + 4)); } }
#pragma unroll
        for (int q = 0; q < 4; ++q) { const size_t i = i0 + q * stride; if (i >= n8) break; const f32x4 a = av[q], b = bv[q];
        u32x4 w; w.x = cvtpk(a[0], a[1]); w.y = cvtpk(a[2], a[3]); w.z = cvtpk(b[0], b[1]); w.w = cvtpk(b[2], b[3]);
        *(u32x4*)(pb + 8 * i) = w; } }
}
__device__ __forceinline__ void cumsum_seq(const float* lf, float* c, char* lds) {
    int tid_l = threadIdx.x; asm volatile("" : "+v"(tid_l));
    const int tid = tid_l, lane = tid & 63, wave = tid >> 6;
    float* sh = (float*)lds;
    const f32x4 a = *(const f32x4*)(lf + tid * 8), b = *(const f32x4*)(lf + tid * 8 + 4);
    float v[8] = {a[0], a[1], a[2], a[3], b[0], b[1], b[2], b[3]};
#pragma unroll
    for (int i = 1; i < 8; ++i) v[i] += v[i - 1];
    float x = v[7];
#pragma unroll
    for (int o = 1; o < 64; o <<= 1) { const float t = __int_as_float(__builtin_amdgcn_ds_bpermute((lane - o) << 2, __float_as_int(x))); if (lane >= o) x += t; }
    if (lane == 63) sh[wave] = x;
    __syncthreads();
    float woff = 0.f;
    for (int w = 0; w < wave; ++w) woff += sh[w];
    const float ex = x - v[7] + woff;
    constexpr float L2E = 1.4426950408889634f;
    f32x4 oa = {(v[0] + ex) * L2E, (v[1] + ex) * L2E, (v[2] + ex) * L2E, (v[3] + ex) * L2E}, ob = {(v[4] + ex) * L2E, (v[5] + ex) * L2E, (v[6] + ex) * L2E, (v[7] + ex) * L2E};
    *(f32x4*)(c + tid * 8) = oa; *(f32x4*)(c + tid * 8 + 4) = ob;
    __syncthreads();
}
template <int LAYER>
__device__ __forceinline__ void nr_pass(const Params& P, bfr* proj, int G, int blk) {
    int tid_l = threadIdx.x; asm volatile("" : "+v"(tid_l));
    const int tid = tid_l, j = tid & 15, sg = (tid >> 4) & 15, rsel = tid >> 8, ln = tid & 63;
    int col, gw; const float* gain; float scale; bool rope;
    if (LAYER == 0) {
        if (sg < 4) { col = sg * 128; gw = 64; gain = P.qn_a; scale = 0.125f; rope = true; }
        else if (sg < 8) { col = 512 + (sg - 4) * 128; gw = 64; gain = P.kn_a; scale = 1.f; rope = true; }
        else if (sg < 12) { col = 1536 + (sg - 8) * 128; gw = 128; gain = P.qn_b; scale = 0.08838834764831845f; rope = false; }
        else { col = 2048 + (sg - 12) * 128; gw = 128; gain = P.kn_b; scale = 1.f; rope = false; }
    } else {
        if (sg < 8) { col = sg * 128; gw = 128; gain = P.qn_c; scale = 0.08838834764831845f; rope = true; }
        else { col = 1024 + (sg - 8) * 128; gw = 128; gain = P.kn_c; scale = 1.f; rope = true; }
    }
    const int jj = (gw == 128) ? j : (j & 7);
    float gn[8];
#pragma unroll
    for (int e = 0; e < 8; ++e) gn[e] = gain[jj * 8 + e];
    const int half = gw / 8, pd = (gw == 128) ? 2 : 1;
    const bool rl = rope && (jj < ((gw == 128) ? 4 : 2));
    const bool isx2 = (gw == 128) ? ((jj & 2) != 0) : ((jj & 1) != 0);
    const int ibase = (gw == 128) ? (jj & 1) * 8 : 0;
    float invf[8];
#pragma unroll
    for (int e = 0; e < 8; ++e) invf[e] = expf(-13.122363377404328f * (float)(ibase + e) / (float)half);
    for (int rp0 = blk; rp0 < TOK / 2; rp0 += 4 * G) {
        u32x4 rawv[4]; float posv[4];
#pragma unroll
        for (int q = 0; q < 4; ++q) { const int rp = rp0 + q * G; if (rp < TOK / 2) { const int row = rp * 2 + rsel;
            rawv[q] = *(const u32x4*)(proj + (size_t)row * NPROJ + col + j * 8); posv[q] = rl ? (float)P.positions[row] : 0.f; } }
#pragma unroll
        for (int q = 0; q < 4; ++q) { const int rp = rp0 + q * G; if (rp >= TOK / 2) break;
        const int row = rp * 2 + rsel;
        bfr* ptr = proj + (size_t)row * NPROJ + col + j * 8;
        const u32x4 raw = rawv[q];
        float f[8] = {__uint_as_float(raw.x << 16), __uint_as_float(raw.x & 0xffff0000u), __uint_as_float(raw.y << 16), __uint_as_float(raw.y & 0xffff0000u),
                      __uint_as_float(raw.z << 16), __uint_as_float(raw.z & 0xffff0000u), __uint_as_float(raw.w << 16), __uint_as_float(raw.w & 0xffff0000u)};
        float ss = 0.f;
#pragma unroll
        for (int e = 0; e < 8; ++e) ss += f[e] * f[e];
        ss += shx(ss, 1, ln); ss += shx(ss, 2, ln); ss += shx(ss, 4, ln);
        { const float t = shx(ss, 8, ln); if (gw == 128) ss += t; }
        const float rs = __builtin_amdgcn_rsqf(ss / (float)gw + RMS_EPS);
        float v[8], pr[8];
#pragma unroll
        for (int e = 0; e < 8; ++e) v[e] = f[e] * rs * gn[e];
#pragma unroll
        for (int e = 0; e < 8; ++e) pr[e] = shx(v[e], pd, ln);
        if (rl) { const float pos = posv[q];
#pragma unroll
            for (int e = 0; e < 8; ++e) { const float ang = pos * invf[e]; const double rev = (double)ang * 0.15915494309189535; const float fr = (float)(rev - rint(rev));
                const float sn = __builtin_amdgcn_sinf(fr), cs = __builtin_amdgcn_cosf(fr);
                v[e] = isx2 ? (v[e] * cs + pr[e] * sn) : (v[e] * cs - pr[e] * sn); } }
        u32x4 w; w.x = cvtpk(v[0] * scale, v[1] * scale); w.y = cvtpk(v[2] * scale, v[3] * scale); w.z = cvtpk(v[4] * scale, v[5] * scale); w.w = cvtpk(v[6] * scale, v[7] * scale);
        *(u32x4*)ptr = w; }
    }
}

__device__ __forceinline__ void store_pair_bf16(bfr* p, float v, int r32) { const float vn = __shfl_xor(v, 1); if ((r32 & 1) == 0) *(unsigned*)p = cvtpk(v, vn); }

__device__ __forceinline__ float bflo(unsigned w) { return __uint_as_float(w << 16); }
__device__ __forceinline__ float bfhi(unsigned w) { return __uint_as_float(w & 0xffff0000u); }
__device__ __forceinline__ void phase_attn0(const Params& P, char* lds, int G, int blk) {
    unsigned char* ws = P.ws;
    const bfr* proj = (const bfr*)(ws + WS_PROJ); bfr* mixed = (bfr*)(ws + WS_CC); float* o1s = (float*)(ws + WS_B); const float* cc = (const float*)(ws + WS_C);
    int tid_l = threadIdx.x; asm volatile("" : "+v"(tid_l));
    const int tid = tid_l, wid = __builtin_amdgcn_readfirstlane(tid >> 6), lane = tid & 63, r32 = lane & 31, hi = lane >> 5;
    float lam;
    { const float a = wave_sum(P.lam_q1[lane] * P.lam_k1[lane], lane), b = wave_sum(P.lam_q2[lane] * P.lam_k2[lane], lane); lam = expf(a) - expf(b) + LAM_INIT0; }
    const int vblk = (G % 8 == 0) ? (blk % 8) * (G / 8) + blk / 8 : blk;
    att::bf16x8 qr[8]; bool have_q = false;
    for (int w = vblk; w < 256; w += G) {
        const int bh = w >> 3, s = w & 7, b = bh >> 2, h = bh & 3;
        const size_t tok0 = (size_t)b * SEQ;
        for (int pass = 0; pass < 2; ++pass) {
            const int qb = pass == 0 ? 15 - s : s;
            att::f32x16 o[4]; float m_reg, l_reg;
            att::Unit U; U.stride = NPROJ; U.q0 = qb * 256; U.j_lo = 0; U.j_hi = (qb + 1) * 4; U.W = 1 << 29;
            U.Q = proj + tok0 * NPROJ + 1536 + h * 128; U.K = proj + tok0 * NPROJ + 2048 + h * 128; U.V = proj + tok0 * NPROJ + 2560 + h * 128; U.c = cc + (size_t)bh * SEQ;
            att::unit_core<128, true, false>(U, lds, o, m_reg, l_reg, qr, have_q, proj + tok0 * NPROJ + h * 128, NPROJ, U.q0, 4); have_q = true;
            { int ln_ = lane; asm volatile("" : "+v"(ln_)); const int ch = ln_ & 7, half = (ln_ >> 3) & 1, r4 = ln_ >> 4;
              const float* stg = (const float*)(lds + wid * 16384) + r4 * 128 + half * 64 + 8 * ch;
              const size_t tk = tok0 + U.q0 + wid * 32 + r4; const int c0 = 512 + h * 128 + half * 64 + 8 * ch;
              const bfr* zl = proj + tk * NPROJ + 3072 + c0; bfr* ml = mixed + tk * DM + c0;
              u32x4 zq[8];
#pragma unroll
              for (int j = 0; j < 8; ++j) zq[j] = __builtin_nontemporal_load((const u32x4*)(zl + (size_t)j * 4 * NPROJ));
#pragma unroll
              for (int j = 0; j < 8; ++j) { const f32x4 a = *(const f32x4*)(stg + j * 512), c = *(const f32x4*)(stg + j * 512 + 4); const u32x4 z = zq[j]; u32x4 wv;
                  wv.x = cvtpk(a[0] * silu_f(bflo(z.x)), a[1] * silu_f(bfhi(z.x))); wv.y = cvtpk(a[2] * silu_f(bflo(z.y)), a[3] * silu_f(bfhi(z.y)));
                  wv.z = cvtpk(c[0] * silu_f(bflo(z.z)), c[1] * silu_f(bfhi(z.z))); wv.w = cvtpk(c[2] * silu_f(bflo(z.w)), c[3] * silu_f(bfhi(z.w)));
                  *(u32x4*)(ml + (size_t)j * 4 * DM) = wv; } }
            __syncthreads();
            U.V = proj + tok0 * NPROJ + 1024 + h * 128; U.c = nullptr;
            U.Q = proj + tok0 * NPROJ + h * 128; U.K = proj + tok0 * NPROJ + 512 + h * 128;
            att::unit_core<64, false, false>(U, lds, o, m_reg, l_reg, qr, true, U.Q + 64, NPROJ, U.q0, 4);
            { int ln_ = lane; asm volatile("" : "+v"(ln_)); const int ch = ln_ & 7, half = (ln_ >> 3) & 1, r4 = ln_ >> 4;
              const float* stg = (const float*)(lds + wid * 16384) + r4 * 128 + half * 64 + 8 * ch;
              float* ol = o1s + (tok0 + U.q0 + wid * 32 + r4) * 512 + h * 128 + half * 64 + 8 * ch;
#pragma unroll
              for (int j = 0; j < 8; ++j) { *(f32x4*)(ol + (size_t)j * 4 * 512) = *(const f32x4*)(stg + j * 512); *(f32x4*)(ol + (size_t)j * 4 * 512 + 4) = *(const f32x4*)(stg + j * 512 + 4); } }
            __syncthreads();
            U.Q += 64; U.K += 64;
            {
              const bfr* nq = nullptr; int nq0 = 0, nfr = 0;
              if (pass == 0) { nq = proj + tok0 * NPROJ + 1536 + h * 128; nq0 = s * 256; nfr = 8; }
              else if (w + G < 256) { const int w2 = w + G, bh2 = w2 >> 3, s2 = w2 & 7; nq = proj + (size_t)(bh2 >> 2) * SEQ * NPROJ + 1536 + (bh2 & 3) * 128; nq0 = (15 - s2) * 256; nfr = 8; }
              att::unit_core<64, false, false>(U, lds, o, m_reg, l_reg, qr, true, nq, NPROJ, nq0, nfr); }
            { int ln_ = lane; asm volatile("" : "+v"(ln_)); const int ch = ln_ & 7, half = (ln_ >> 3) & 1, r4 = ln_ >> 4;
              const float* stg = (const float*)(lds + wid * 16384) + r4 * 128 + half * 64 + 8 * ch;
              const size_t tk = tok0 + U.q0 + wid * 32 + r4; const int c0 = h * 128 + half * 64 + 8 * ch;
              const float* ol = o1s + tk * 512 + c0; const bfr* zl = proj + tk * NPROJ + 3072 + c0; bfr* ml = mixed + tk * DM + c0;
              const f32x4 ga = *(const f32x4*)(P.subln_g + half * 64 + 8 * ch) * (1.f - LAM_INIT0), gb = *(const f32x4*)(P.subln_g + half * 64 + 8 * ch + 4) * (1.f - LAM_INIT0);
#pragma unroll
              for (int jh = 0; jh < 2; ++jh) { f32x4 va[4], vc[4]; u32x4 zq[4];
#pragma unroll
                  for (int jj = 0; jj < 4; ++jj) { const int j = jh * 4 + jj; va[jj] = *(const f32x4*)(ol + (size_t)j * 4 * 512); vc[jj] = *(const f32x4*)(ol + (size_t)j * 4 * 512 + 4);
                      zq[jj] = __builtin_nontemporal_load((const u32x4*)(zl + (size_t)j * 4 * NPROJ)); }
#pragma unroll
                  for (int jj = 0; jj < 4; ++jj) { const int j = jh * 4 + jj;
                      const f32x4 a = va[jj] - *(const f32x4*)(stg + j * 512) * lam, c = vc[jj] - *(const f32x4*)(stg + j * 512 + 4) * lam;
                      float ss = ((a[0] * a[0] + a[1] * a[1]) + (a[2] * a[2] + a[3] * a[3])) + ((c[0] * c[0] + c[1] * c[1]) + (c[2] * c[2] + c[3] * c[3]));
                      ss += __int_as_float(__builtin_amdgcn_ds_bpermute((ln_ ^ 1) << 2, __float_as_int(ss))); ss += __int_as_float(__builtin_amdgcn_ds_bpermute((ln_ ^ 2) << 2, __float_as_int(ss)));
                      ss += __int_as_float(__builtin_amdgcn_ds_bpermute((ln_ ^ 4) << 2, __float_as_int(ss))); ss += __int_as_float(__builtin_amdgcn_ds_bpermute((ln_ ^ 8) << 2, __float_as_int(ss)));
                      const float rs = __builtin_amdgcn_rsqf(ss * (1.f / 128.f) + RMS_EPS);
                      const f32x4 oa = a * ga * rs, oc = c * gb * rs; const u32x4 z = zq[jj]; u32x4 wv;
                      wv.x = cvtpk(oa[0] * silu_f(bflo(z.x)), oa[1] * silu_f(bfhi(z.x))); wv.y = cvtpk(oa[2] * silu_f(bflo(z.y)), oa[3] * silu_f(bfhi(z.y)));
                      wv.z = cvtpk(oc[0] * silu_f(bflo(z.z)), oc[1] * silu_f(bfhi(z.z))); wv.w = cvtpk(oc[2] * silu_f(bflo(z.w)), oc[3] * silu_f(bfhi(z.w)));
                      *(u32x4*)(ml + (size_t)j * 4 * DM) = wv; } } }
            __syncthreads();
        }
    }
}
__device__ __forceinline__ void phase_attn1(const Params& P, char* lds, int G, int blk) {
    unsigned char* ws = P.ws;
    const bfr* proj = (const bfr*)(ws + WS_PROJ); float* lse = (float*)(ws + WS_LSE);
    int tid_l = threadIdx.x; asm volatile("" : "+v"(tid_l));
    const int tid = tid_l, wid = __builtin_amdgcn_readfirstlane(tid >> 6), lane = tid & 63, r32 = lane & 31, hi = lane >> 5;
    const int vblk = (G % 8 == 0) ? (blk % 8) * (G / 8) + blk / 8 : blk;
    att::bf16x8 qr[8]; bool have_q = false;
    for (int u = vblk; u < 3072; u += G) {
        const int bh = u / 48, rem = u % 48, pat = rem >> 4, idx = rem & 15, b = bh >> 3, h = bh & 7;
        const int dil = pat == 0 ? 1 : pat == 1 ? 4 : 16;
        const int res = idx % dil, qb = idx / dil;
        const size_t tok0 = (size_t)b * SEQ + res;
        const bfr* nq = nullptr; long nstr = 0; int nq0 = 0, nfr = 0;
        if (u + G < 3072) { const int u2 = u + G, bh2 = u2 / 48, rem2 = u2 % 48, pat2 = rem2 >> 4, idx2 = rem2 & 15; const int dil2 = pat2 == 0 ? 1 : pat2 == 1 ? 4 : 16;
            nq = proj + ((size_t)(bh2 >> 3) * SEQ + (idx2 % dil2)) * NPROJ + (bh2 & 7) * 128; nstr = (long)NPROJ * dil2; nq0 = (idx2 / dil2) * 256; nfr = 8; }
        bfr* part = pat == 2 ? (bfr*)P.out : (bfr*)(ws + WS_A + (size_t)pat * 64 * MiB);
        att::f32x16 o[4]; float m_reg, l_reg;
        att::Unit U; U.stride = (long)NPROJ * dil; U.q0 = qb * 256; U.j_lo = qb == 0 ? 0 : (qb * 256 - 128) / 64; U.j_hi = (qb + 1) * 4; U.W = 129; U.c = nullptr;
        U.Q = proj + tok0 * NPROJ + h * 128; U.K = proj + tok0 * NPROJ + 1024 + h * 128; U.V = proj + tok0 * NPROJ + 2048 + h * 128;
        att::unit_core<128, false, true>(U, lds, o, m_reg, l_reg, qr, have_q, nq, nstr, nq0, nfr); have_q = true;
        if (hi == 0) { const size_t tk = tok0 + (size_t)(U.q0 + wid * 32 + r32) * dil; lse[((size_t)pat * TOK + tk) * 8 + h] = m_reg * 0.6931471805599453f + __logf(l_reg); }
        {
          int ln_ = lane; asm volatile("" : "+v"(ln_)); const int ch = ln_ & 7, half = (ln_ >> 3) & 1, r4 = ln_ >> 4;
          const float* stg = (const float*)(lds + wid * 16384) + r4 * 128 + half * 64 + 8 * ch;
          bfr* pl = part + (tok0 + (size_t)(U.q0 + wid * 32 + r4) * dil) * DM + h * 128 + half * 64 + 8 * ch;
          const size_t jstep = (size_t)4 * dil * DM;
#pragma unroll
          for (int j = 0; j < 8; ++j) { const f32x4 a = *(const f32x4*)(stg + j * 4 * 128), c = *(const f32x4*)(stg + j * 4 * 128 + 4); u32x4 wv;
              wv.x = cvtpk(a[0], a[1]); wv.y = cvtpk(a[2], a[3]); wv.z = cvtpk(c[0], c[1]); wv.w = cvtpk(c[2], c[3]);
              __builtin_nontemporal_store(wv, (u32x4*)(pl + j * jstep)); } }
        __syncthreads();
    }
}
__device__ __forceinline__ void phase_merge1(const Params& P, int G, int blk) {
    unsigned char* ws = P.ws;
    const bfr* proj = (const bfr*)(ws + WS_PROJ); const float* lse = (const float*)(ws + WS_LSE);
    bfr* p0 = (bfr*)(ws + WS_A); const bfr* p1 = (const bfr*)(ws + WS_B); const bfr* p2 = (const bfr*)P.out;
    const size_t n8 = (size_t)TOK * DM / 8;
    int tid_l = threadIdx.x; asm volatile("" : "+v"(tid_l));
    const size_t stride = (size_t)G * 512;
    for (size_t i0 = (size_t)blk * 512 + tid_l; i0 < n8; i0 += 4 * stride) {
        u32x4 av[4], bv[4], cv[4], zv[4]; float lv[4][3];
#pragma unroll
        for (int q = 0; q < 4; ++q) { const size_t i = i0 + q * stride; if (i < n8) { const size_t tk = i >> 7; const int c = (int)(i & 127) * 8, h = c >> 7;
            lv[q][0] = lse[((size_t)0 * TOK + tk) * 8 + h]; lv[q][1] = lse[((size_t)1 * TOK + tk) * 8 + h]; lv[q][2] = lse[((size_t)2 * TOK + tk) * 8 + h];
            av[q] = __builtin_nontemporal_load((const u32x4*)(p0 + tk * DM + c)); bv[q] = __builtin_nontemporal_load((const u32x4*)(p1 + tk * DM + c)); cv[q] = __builtin_nontemporal_load((const u32x4*)(p2 + tk * DM + c)); zv[q] = __builtin_nontemporal_load((const u32x4*)(proj + tk * NPROJ + 3072 + c)); } }
#pragma unroll
        for (int q = 0; q < 4; ++q) { const size_t i = i0 + q * stride; if (i >= n8) break; const size_t tk = i >> 7; const int c = (int)(i & 127) * 8;
        const float l0 = lv[q][0], l1 = lv[q][1], l2 = lv[q][2];
        const float mx = fmaxf(l0, fmaxf(l1, l2)); float w0 = __expf(l0 - mx), w1 = __expf(l1 - mx), w2 = __expf(l2 - mx); const float inv = 1.f / (w0 + w1 + w2); w0 *= inv; w1 *= inv; w2 *= inv;
        const u32x4 a = av[q], bq = bv[q], cq = cv[q], zq = zv[q];
        u32x4 ow;
#pragma unroll
        for (int k = 0; k < 4; ++k) {
            const float alo = __uint_as_float(a[k] << 16), ahi = __uint_as_float(a[k] & 0xffff0000u), blo = __uint_as_float(bq[k] << 16), bhi = __uint_as_float(bq[k] & 0xffff0000u);
            const float clo = __uint_as_float(cq[k] << 16), chi = __uint_as_float(cq[k] & 0xffff0000u), zlo = __uint_as_float(zq[k] << 16), zhi = __uint_as_float(zq[k] & 0xffff0000u);
            ow[k] = cvtpk((w0 * alo + w1 * blo + w2 * clo) * silu_f(zlo), (w0 * ahi + w1 * bhi + w2 * chi) * silu_f(zhi)); }
        *(u32x4*)(p0 + tk * DM + c) = ow; } }
}

#define LAS __attribute__((address_space(3)))
#define XB_TMO      128
#define XB_XCNT(j)  (256  + 64 * (j))
#define XB_XSUB(j)  (1280 + 64 * (j))
#define XB_XGEN(j)  (2304 + 64 * (j))
#define XB_TOP      3328
#define XB_TOPGEN   3392
#define XCD_BAR_WORDS 3456
#define XB_SPIN_CAP (1u << 18)

__device__ __forceinline__ unsigned xb_ld(unsigned* p)              { return __hip_atomic_load(p, __ATOMIC_RELAXED, __HIP_MEMORY_SCOPE_AGENT); }
__device__ __forceinline__ unsigned xb_add(unsigned* p, unsigned v) { return __hip_atomic_fetch_add(p, v, __ATOMIC_RELAXED, __HIP_MEMORY_SCOPE_AGENT); }
__device__ __forceinline__ unsigned xb_xcc_id() { return (unsigned)__builtin_amdgcn_s_getreg((3 << 11) | 20) & 0xFu; }
#define XB_SPIN(cond, bar) do { unsigned _sp = 0; while (cond) { __builtin_amdgcn_s_sleep(1); \
    if ((++_sp & 255u) == 0u) { if (xb_ld(&(bar)[XB_TMO])) break; if (_sp > XB_SPIN_CAP) { atomicAdd(&(bar)[XB_TMO], 1u); break; } } } } while (0)

struct XcdBarrier {
    unsigned* bar; unsigned x;
    volatile LAS unsigned* st;
};

__device__ __forceinline__ XcdBarrier xcd_barrier_post(unsigned* bar, volatile LAS unsigned* st) {
    XcdBarrier b; b.bar = bar; b.x = xb_xcc_id(); b.st = st;
    if (threadIdx.x == 0) (void)xb_add(&bar[XB_XCNT(b.x)], 1u);
    return b;
}
__device__ __forceinline__ void xcd_barrier_complete(unsigned* bar, unsigned x, unsigned& nloc, unsigned& nx) {
    const unsigned G = gridDim.x * gridDim.y * gridDim.z;
    unsigned sum, cnt, mine, sp = 0u;
    for (;;) {
        sum = 0u; cnt = 0u; mine = 0u;
#pragma unroll
        for (unsigned j = 0; j < 16; ++j) { const unsigned c = xb_ld(&bar[XB_XCNT(j)]); sum += c; cnt += (c > 0u) ? 1u : 0u; mine = (j == x) ? c : mine; }
        if (sum == G) break;
        __builtin_amdgcn_s_sleep(1);
        if ((++sp & 255u) == 0u) { if (xb_ld(&bar[XB_TMO])) break; if (sp > XB_SPIN_CAP) { atomicAdd(&bar[XB_TMO], 1u); break; } }
    }
    nloc = mine > 0u ? mine : 1u; nx = cnt > 0u ? cnt : 1u;
}

__device__ __forceinline__ void xcd_barrier(const XcdBarrier& b) {
    asm volatile("s_waitcnt vmcnt(0)" ::: "memory");
    __syncthreads();
    if (threadIdx.x == 0) {
        unsigned* bar = b.bar;
        __builtin_amdgcn_s_waitcnt(0);
        unsigned nloc = b.st[0], nx = b.st[1];
        if (nloc == 0u) { xcd_barrier_complete(bar, b.x, nloc, nx); b.st[0] = nloc; b.st[1] = nx; }
        const unsigned old = xb_add(&bar[XB_XSUB(b.x)], 1u);
        const unsigned gen = old / nloc;
        if (old + 1u == (gen + 1u) * nloc) {
            __builtin_amdgcn_fence(__ATOMIC_RELEASE, "agent");
            asm volatile("s_waitcnt vmcnt(0)" ::: "memory");
            const unsigned og = xb_add(&bar[XB_TOP], 1u);
            const unsigned tg = og / nx;
            if (og + 1u == (tg + 1u) * nx) xb_add(&bar[XB_TOPGEN], 1u);
            else XB_SPIN(xb_ld(&bar[XB_TOPGEN]) == tg, bar);
            __builtin_amdgcn_fence(__ATOMIC_ACQUIRE, "agent");
            xb_add(&bar[XB_XGEN(b.x)], 1u);
            asm volatile("s_waitcnt vmcnt(0)" ::: "memory");
        } else {
            XB_SPIN(xb_ld(&bar[XB_XGEN(b.x)]) == gen, bar);
            __builtin_amdgcn_fence(__ATOMIC_ACQUIRE, "agent");
            asm volatile("s_waitcnt vmcnt(0)" ::: "memory");
        }
    }
    __syncthreads();
}

#ifndef PH
#define PH 4095
#endif
#ifndef DUP
#define DUP 0
#endif
__global__ void __launch_bounds__(512, 2) fwd_mega(Params P) {
    extern __shared__ __attribute__((aligned(16))) unsigned char lds_raw[];
    cg::grid_group grid = cg::this_grid();
    char* lds = (char*)lds_raw; PG8_LAS unsigned char* lds3 = (PG8_LAS unsigned char*)lds_raw;
    unsigned char* ws = P.ws; const int G = gridDim.x, blk = blockIdx.x;
    bfr* proj = (bfr*)(ws + WS_PROJ); bfr* bufA = (bfr*)(ws + WS_A); bfr* bufB = (bfr*)(ws + WS_B); bfr* bufC = (bfr*)(ws + WS_CC); bfr* pb = (bfr*)(ws + WS_PB);
    float* ssq = (float*)(ws + WS_SSQ);
    volatile LAS unsigned* bst = (volatile LAS unsigned*)(lds3 + 134144);
    if (threadIdx.x < 2) bst[threadIdx.x] = 0u;
    __syncthreads();
    XcdBarrier xbar = xcd_barrier_post((unsigned*)(ws + WS_BAR), bst);
    if (G == 0x7fffffff) grid.sync();
#if PH & 1
    phase_prologue(P, lds, G, blk);
#endif
#if DUP & 1
    grid.sync(); phase_prologue(P, lds, G, blk); convert_p(P.p, pb, G, blk);
#endif
#if DUP & 4096
    for (int i = 0; i < 10; ++i) xcd_barrier(xbar);
#endif
    xcd_barrier(xbar);
#if PH & 2
    { pg8::Gemm g{bufA, (const bfr*)(ws + WS_W0T), TOK, NPROJ, DM}; pg8::StaticOrder S; S.init(TOK, NPROJ, G, blk);
      for (int w = blk; w < 32; w += G) cumsum_seq((const float*)(ws + WS_LF) + (size_t)w * SEQ, (float*)(ws + WS_C) + (size_t)w * SEQ, lds);
      EpiProjNR<0> E{proj, (const float*)(ws + WS_RSTD0), nullptr, (const float*)(ws + WS_ROPE), P.qn_a, P.kn_a, P.qn_b, P.kn_b, (float*)(lds + LDS_XCH)};
      pg8::gemm_phase<EpiProjNR<0>, pg8::StaticOrder, true, true>(lds3, g, S, E);
    }
#endif
    xcd_barrier(xbar);
#if PH & 8
    phase_late_weights(P, lds, G, blk); convert_p(P.p, pb, G, blk);
    phase_attn0(P, lds, G, blk);
#endif
#if DUP & 8
    xcd_barrier(xbar); phase_attn0(P, lds, G, blk);
#endif
    xcd_barrier(xbar);
#if PH & 16
    { pg8::Gemm g{bufC, (const bfr*)(ws + WS_WO0T), TOK, DM, DM}; pg8::StaticOrder S; S.init(TOK, DM, G, blk);
      EpiRes<false> E{P.x, nullptr, bufA};
      pg8::gemm_phase<EpiRes<false>, pg8::StaticOrder, true, true>(lds3, g, S, E);
    }
#endif
    xcd_barrier(xbar);
#if PH & 32
    { pg8::Gemm g{pb, (const bfr*)(ws + WS_WP0T), TOK, DM, PLE}; pg8::StaticOrder S; S.init(TOK, DM, G, blk);
      EpiT1 E{bufB};
      pg8::gemm_phase<EpiT1, pg8::StaticOrder, true, true>(lds3, g, S, E);
#if DUP & 32
      xcd_barrier(xbar); pg8::gemm_phase<EpiT1, pg8::StaticOrder, true, true>(lds3, g, S, E);
#endif
    }
    { pg8::Gemm g{bufA, (const bfr*)(ws + WS_WG0T), TOK, DM, DM}; pg8::StaticOrder S; S.init(TOK, DM, G, blk);
      EpiGate E{bufA, bufB, bufC, ssq, nullptr};
      pg8::gemm_phase<EpiGate, pg8::StaticOrder, true, true>(lds3, g, S, E); }
#endif
    xcd_barrier(xbar);
#if PH & 64
    { pg8::Gemm g{bufC, (const bfr*)(ws + WS_W1T), TOK, NPROJ, DM}; pg8::StaticOrder S; S.init(TOK, NPROJ, G, blk);
      EpiProjNR<1> E{proj, nullptr, ssq, (const float*)(ws + WS_ROPE), nullptr, nullptr, P.qn_c, P.kn_c, (float*)(lds + LDS_XCH)};
      pg8::gemm_phase<EpiProjNR<1>, pg8::StaticOrder, true, true>(lds3, g, S, E); }
#endif
    xcd_barrier(xbar);
#if PH & 256
    phase_attn1(P, lds, G, blk);
#endif
#if DUP & 256
    xcd_barrier(xbar); phase_attn1(P, lds, G, blk);
#endif
    xcd_barrier(xbar);
#if PH & 512
    phase_merge1(P, G, blk); convert_p(P.p + (size_t)TOK * PLE, pb, G, blk);
#endif
    xcd_barrier(xbar);
#if PH & 1024
    { pg8::Gemm g{bufA, (const bfr*)(ws + WS_WO1T), TOK, DM, DM}; pg8::StaticOrder S; S.init(TOK, DM, G, blk);
      EpiRes<true> E{nullptr, bufC, bufB};
      pg8::gemm_phase<EpiRes<true>, pg8::StaticOrder, true, true>(lds3, g, S, E); }
#endif
    xcd_barrier(xbar);
#if PH & 2048
    { pg8::Gemm g{pb, (const bfr*)(ws + WS_WP1T), TOK, DM, PLE}; pg8::StaticOrder S; S.init(TOK, DM, G, blk);
      EpiT1 E{bufA};
      pg8::gemm_phase<EpiT1, pg8::StaticOrder, true, true>(lds3, g, S, E); }
    { pg8::Gemm g{bufB, (const bfr*)(ws + WS_WG1T), TOK, DM, DM}; pg8::StaticOrder S; S.init(TOK, DM, G, blk);
      EpiGate E{bufB, bufA, nullptr, nullptr, P.out};
      pg8::gemm_phase<EpiGate, pg8::StaticOrder, true, true>(lds3, g, S, E); }
#endif
}

extern "C" void kernel_launch(void* const* d_in, const int* in_sizes, int n_in, void* d_out, int out_size, void* d_ws, size_t ws_size, hipStream_t stream) {
    static int grid = 0;
    if (!grid) {
        if (n_in != 22 || out_size != TOK * DM || ws_size < WS_END) { fprintf(stderr, "kernel_launch: unexpected shapes (n_in %d out %d ws %zu)\n", n_in, out_size, ws_size); grid = -1; return; }
        int dev = 0, cus = 0, per_cu = 0;
        (void)hipGetDevice(&dev); (void)hipDeviceGetAttribute(&cus, hipDeviceAttributeMultiprocessorCount, dev);
        (void)hipFuncSetAttribute((const void*)fwd_mega, hipFuncAttributeMaxDynamicSharedMemorySize, LDS_BYTES);
        (void)hipOccupancyMaxActiveBlocksPerMultiprocessor(&per_cu, (const void*)fwd_mega, 512, LDS_BYTES);
        if (per_cu < 1) per_cu = 1;
        grid = cus * per_cu;
        fprintf(stderr, "grid %d (cus %d per_cu %d) ws %zu\n", grid, cus, per_cu, ws_size);
    }
    if (grid < 0) return;
    Params p{};
    p.x = (const float*)d_in[0]; p.p = (const float*)d_in[1]; p.positions = (const int*)d_in[2]; p.norm_g = (const float*)d_in[3]; p.w_in_even = (const float*)d_in[4];
    p.b_forget = (const float*)d_in[5]; p.qn_a = (const float*)d_in[6]; p.kn_a = (const float*)d_in[7]; p.qn_b = (const float*)d_in[8]; p.kn_b = (const float*)d_in[9];
    p.lam_q1 = (const float*)d_in[10]; p.lam_k1 = (const float*)d_in[11]; p.lam_q2 = (const float*)d_in[12]; p.lam_k2 = (const float*)d_in[13]; p.subln_g = (const float*)d_in[14];
    p.w_out_even = (const float*)d_in[15]; p.w_in_odd = (const float*)d_in[16]; p.qn_c = (const float*)d_in[17]; p.kn_c = (const float*)d_in[18]; p.w_out_odd = (const float*)d_in[19];
    p.w_ple = (const float*)d_in[20]; p.w_ple_gate = (const float*)d_in[21]; p.out = (float*)d_out; p.ws = (unsigned char*)d_ws;
    (void)hipMemsetAsync((char*)d_ws + WS_BAR, 0, BAR_BYTES, stream);
    void* args[] = {&p};
    hipError_t e = hipLaunchCooperativeKernel((const void*)fwd_mega, dim3(grid), dim3(512), args, LDS_BYTES, stream);
    if (e != hipSuccess) fprintf(stderr, "cooperative launch failed: %s (grid %d)\n", hipGetErrorString(e), grid);
}
```
